# Optimizing an MI355X kernel written in HIP

```python
import jax, jax.numpy as jnp
from jax import lax
import numpy as np

D_MODEL = 2048
BATCH = 2
SEQ = 8192
DEPTH = 2

GRID_W = 64
CTX_LEN = 256
N_MOD = 9
FFN_DIM = 5632
HEAD_DIM = 128
N_FOURIER_GROUPS = 4
FOURIER_GROUP_DIM = 128
FOURIER_WIDTH = N_FOURIER_GROUPS * FOURIER_GROUP_DIM
N_Q_HEADS = (D_MODEL - FOURIER_WIDTH) // HEAD_DIM
N_KV_HEADS = 4
Q_GROUP = N_Q_HEADS // N_KV_HEADS
ATTN_Q_WIDTH = N_Q_HEADS * HEAD_DIM
ATTN_KV_WIDTH = N_KV_HEADS * HEAD_DIM
AB_IN_WIDTH = FOURIER_WIDTH + ATTN_Q_WIDTH + 2 * ATTN_KV_WIDTH
AB_OUT_WIDTH = FOURIER_WIDTH + ATTN_Q_WIDTH
ATTN_SCALE = HEAD_DIM ** -0.5
Q_BLOCK = 128
ROPE_AXIS_DIM = HEAD_DIM // 2
ROPE_THETA = 10000.0
HGRN_WIDTH = D_MODEL
HGRN_HEAD_DIM = 128
HGRN_HEADS = HGRN_WIDTH // HGRN_HEAD_DIM
HGRN_IN_WIDTH = 5 * HGRN_WIDTH
HGRN_CHUNK = 64
N_EVEN = (DEPTH + 1) // 2
N_ODD = DEPTH // 2
EPS = 1e-6

kernel_name = 'hybrid_fourier_gqa_hgrn2_macaron'


def rms_norm(x, gain):
    xf = x.astype(jnp.float32)
    y = xf * lax.rsqrt(jnp.mean(xf * xf, axis=-1, keepdims=True) + EPS)
    return (y * gain.astype(jnp.float32)).astype(x.dtype)


def ada_pre(h, gain, shift, scale):
    return rms_norm(h, gain) * (1 + scale) + shift


def swiglu(h, w_in, w_out):
    a, b = jnp.split(h @ w_in, 2, axis=-1)
    return (jax.nn.silu(a) * b) @ w_out


def axial_rope(n_tokens):
    rows = n_tokens // GRID_W
    row_id = jnp.repeat(jnp.arange(rows, dtype=jnp.float32), GRID_W)
    col_id = jnp.tile(jnp.arange(GRID_W, dtype=jnp.float32), rows)
    inv_freq = ROPE_THETA ** (-jnp.arange(0, ROPE_AXIS_DIM, 2, dtype=jnp.float32) / ROPE_AXIS_DIM)
    ang = jnp.concatenate([row_id[:, None] * inv_freq, col_id[:, None] * inv_freq], axis=-1)
    return jnp.cos(ang), jnp.sin(ang)


def apply_axial_rope(x, cos, sin):
    B, L, H, _ = x.shape
    nf = ROPE_AXIS_DIM // 2
    xf = x.astype(jnp.float32).reshape(B, L, H, 2, 2, nf)
    c = cos.reshape(L, 1, 2, nf)
    s = sin.reshape(L, 1, 2, nf)
    x1, x2 = xf[..., 0, :], xf[..., 1, :]
    y = jnp.stack([x1 * c - x2 * s, x1 * s + x2 * c], axis=-2)
    return y.reshape(B, L, H, HEAD_DIM).astype(x.dtype)


def fourier_mix(f):
    B, n, _ = f.shape
    g = f.astype(jnp.float32).reshape(B, n, N_FOURIER_GROUPS, FOURIER_GROUP_DIM)
    y = jnp.fft.fft2(g, axes=(1, 3), norm='ortho').real
    return y.reshape(B, n, FOURIER_WIDTH).astype(f.dtype)


def gqa_attend(q, k, v):
    B, n = q.shape[:2]
    qg = q.reshape(B, n, N_KV_HEADS, Q_GROUP, HEAD_DIM)
    s = jnp.einsum('bqkgd,bskd->bkgqs', qg, k, preferred_element_type=jnp.float32) * ATTN_SCALE
    p = jax.nn.softmax(s, axis=-1).astype(v.dtype)
    o = jnp.einsum('bkgqs,bskd->bqkgd', p, v)
    return o.reshape(B, n, N_Q_HEADS * HEAD_DIM)


def split_ab(p, qk_norm):
    B, n, _ = p.shape
    f, q, k, v = jnp.split(p, [FOURIER_WIDTH, FOURIER_WIDTH + ATTN_Q_WIDTH,
                               FOURIER_WIDTH + ATTN_Q_WIDTH + ATTN_KV_WIDTH], axis=-1)
    q = rms_norm(q.reshape(B, n, N_Q_HEADS, HEAD_DIM), qk_norm[0])
    k = rms_norm(k.reshape(B, n, N_KV_HEADS, HEAD_DIM), qk_norm[1])
    v = v.reshape(B, n, N_KV_HEADS, HEAD_DIM)
    return f, q, k, v


def fourier_gqa_mixer(a_lat, a_ctx, w_in, qk_norm, w_out, need_ctx_out):
    B, L, _ = a_lat.shape
    f_lat, q_lat, k_lat, v_lat = split_ab(a_lat @ w_in, qk_norm)
    f_ctx, q_ctx, k_ctx, v_ctx = split_ab(a_ctx @ w_in, qk_norm)
    cos, sin = axial_rope(L)
    q_lat = apply_axial_rope(q_lat, cos, sin)
    k_lat = apply_axial_rope(k_lat, cos, sin)
    k_all = jnp.concatenate([k_ctx, k_lat], axis=1)
    v_all = jnp.concatenate([v_ctx, v_lat], axis=1)
    n_blocks = L // Q_BLOCK
    q_blocks = q_lat.reshape(B, n_blocks, Q_BLOCK, N_Q_HEADS, HEAD_DIM).transpose(1, 0, 2, 3, 4)
    attn_lat = lax.map(lambda qb: gqa_attend(qb, k_all, v_all), q_blocks)
    attn_lat = attn_lat.transpose(1, 0, 2, 3).reshape(B, L, ATTN_Q_WIDTH)
    y_lat = jnp.concatenate([fourier_mix(f_lat), attn_lat], axis=-1) @ w_out
    y_ctx = None
    if need_ctx_out:
        attn_ctx = gqa_attend(q_ctx, k_ctx, v_ctx)
        y_ctx = jnp.concatenate([fourier_mix(f_ctx), attn_ctx], axis=-1) @ w_out
    return y_lat, y_ctx


def chunked_gated_scan(q, k, v, log_f, s0):
    B, n, H, _ = q.shape
    nc = n // HGRN_CHUNK

    def chunks(t):
        return t.reshape(B, nc, HGRN_CHUNK, H, t.shape[-1]).transpose(1, 0, 3, 2, 4)

    causal = jnp.tril(jnp.ones((HGRN_CHUNK, HGRN_CHUNK), dtype=bool))[:, :, None]

    def step(S, xs):
        qc, kc, vc, gc = xs
        b = jnp.cumsum(gc, axis=2)
        o_inter = jnp.einsum('bhtk,bhkv->bhtv', qc * jnp.exp(b), S)
        diff = b[:, :, :, None, :] - b[:, :, None, :, :]
        decay = jnp.where(causal, jnp.exp(jnp.where(causal, diff, 0.0)), 0.0)
        a = jnp.einsum('bhtk,bhsk,bhtsk->bhts', qc, kc, decay)
        o = o_inter + jnp.einsum('bhts,bhsv->bhtv', a, vc)
        b_last = b[:, :, -1:, :]
        S_new = jnp.exp(b_last[:, :, 0, :])[..., None] * S + jnp.einsum('bhsk,bhsv->bhkv', kc * jnp.exp(b_last - b), vc)
        return S_new, o

    s_fin, o = lax.scan(step, s0, (chunks(q), chunks(k), chunks(v), chunks(log_f)))
    o = o.transpose(1, 0, 3, 2, 4).reshape(B, n, H, v.shape[-1])
    return o, s_fin


def bidirectional_scan(q, v, k_fw, lf_fw, k_bw, lf_bw, s_fw0, s_bw0):
    o_fw, s_fw = chunked_gated_scan(q, k_fw, v, lf_fw, s_fw0)
    rev = lambda t: jnp.flip(t, axis=1)
    o_bw, s_bw = chunked_gated_scan(rev(q), rev(k_bw), rev(v), rev(lf_bw), s_bw0)
    return o_fw + rev(o_bw), s_fw, s_bw


def hgrn2_project(a, w_in, lower_bound):
    B, n, _ = a.shape
    q, f_fw, f_bw, i, g = jnp.split(a @ w_in, 5, axis=-1)
    heads = lambda t: t.astype(jnp.float32).reshape(B, n, HGRN_HEADS, HGRN_HEAD_DIM)

    def forget(fl):
        fl = fl.astype(jnp.float32)
        log_f = jnp.logaddexp(jnp.log(lower_bound), jnp.log1p(-lower_bound) + jax.nn.log_sigmoid(fl))
        key = (1.0 - lower_bound) * jax.nn.sigmoid(-fl)
        return heads(key), heads(log_f)

    k_fw, lf_fw = forget(f_fw)
    k_bw, lf_bw = forget(f_bw)
    return heads(jax.nn.silu(q)), heads(i), g, k_fw, lf_fw, k_bw, lf_bw


def hgrn2_mixer(a_lat, a_ctx, w_in, lower_bound, o_norm, w_out, need_ctx_out):
    B = a_lat.shape[0]
    s_zero = jnp.zeros((B, HGRN_HEADS, HGRN_HEAD_DIM, HGRN_HEAD_DIM), jnp.float32)
    q_c, i_c, g_c, k_fc, lf_fc, k_bc, lf_bc = hgrn2_project(a_ctx, w_in, lower_bound)
    o_c, s_fw, s_bw = bidirectional_scan(q_c, i_c, k_fc, lf_fc, k_bc, lf_bc, s_zero, s_zero)
    q_l, i_l, g_l, k_fl, lf_fl, k_bl, lf_bl = hgrn2_project(a_lat, w_in, lower_bound)
    o_l, _, _ = bidirectional_scan(q_l, i_l, k_fl, lf_fl, k_bl, lf_bl, s_fw, s_bw)

    def readout(o, g):
        Bo, n = o.shape[:2]
        o = rms_norm(o, o_norm).reshape(Bo, n, HGRN_WIDTH).astype(g.dtype)
        return (o * jax.nn.sigmoid(g)) @ w_out

    y_lat = readout(o_l, g_l)
    y_ctx = readout(o_c, g_c) if need_ctx_out else None
    return y_lat, y_ctx


def setup_inputs(seed: int = 0) -> dict:
    key = jax.random.key(seed)
    ks = jax.random.split(key, 17)
    d = D_MODEL
    nrm = lambda k, shape, std: std * jax.random.normal(k, shape, jnp.float32)
    return {
        'x': nrm(ks[0], (BATCH, SEQ, d), 1.0),
        'c': nrm(ks[1], (BATCH, d), 1.0),
        'ctx': nrm(ks[2], (BATCH, CTX_LEN, d), 1.0),
        'c_ctx': nrm(ks[3], (d,), 1.0),
        'w_mod': nrm(ks[4], (DEPTH, d, N_MOD * d), 0.5 * d ** -0.5),
        'b_mod': nrm(ks[5], (DEPTH, N_MOD * d), 0.01),
        'norm_gains': 1.0 + nrm(ks[6], (DEPTH, 3, d), 0.02),
        'ffn_w_in': nrm(ks[7], (DEPTH, 2, d, 2 * FFN_DIM), d ** -0.5),
        'ffn_w_out': nrm(ks[8], (DEPTH, 2, FFN_DIM, d), FFN_DIM ** -0.5),
        'ab_w_in': nrm(ks[9], (N_EVEN, d, AB_IN_WIDTH), d ** -0.5),
        'qk_norm': 1.0 + nrm(ks[10], (N_EVEN, 2, HEAD_DIM), 0.02),
        'ab_w_out': nrm(ks[11], (N_EVEN, AB_OUT_WIDTH, d), AB_OUT_WIDTH ** -0.5),
        'hgrn_w_in': nrm(ks[12], (N_ODD, d, HGRN_IN_WIDTH), d ** -0.5),
        'hgrn_lb_logits': nrm(ks[13], (DEPTH, HGRN_WIDTH), 0.1),
        'hgrn_o_norm': 1.0 + nrm(ks[14], (N_ODD, HGRN_HEAD_DIM), 0.02),
        'hgrn_w_out': nrm(ks[15], (N_ODD, HGRN_WIDTH, d), HGRN_WIDTH ** -0.5),
        'final_norm': 1.0 + nrm(ks[16], (d,), 0.02),
    }


def reference(x, c, ctx, c_ctx, w_mod, b_mod, norm_gains, ffn_w_in, ffn_w_out, ab_w_in, qk_norm, ab_w_out,
              hgrn_w_in, hgrn_lb_logits, hgrn_o_norm, hgrn_w_out, final_norm):
    lb_cum = jnp.cumsum(jax.nn.softmax(hgrn_lb_logits.astype(jnp.float32), axis=0), axis=0)
    lower_bounds = lb_cum - lb_cum[0]
    h_lat, h_ctx = x, ctx
    for layer in range(DEPTH):
        last = layer == DEPTH - 1
        m_lat = jnp.split((jax.nn.silu(c) @ w_mod[layer] + b_mod[layer])[:, None, :], N_MOD, axis=-1)
        m_ctx = jnp.split((jax.nn.silu(c_ctx) @ w_mod[layer] + b_mod[layer])[None, None, :], N_MOD, axis=-1)
        g0, g1, g2 = norm_gains[layer, 0], norm_gains[layer, 1], norm_gains[layer, 2]
        h_lat = h_lat + 0.5 * m_lat[2] * swiglu(ada_pre(h_lat, g0, m_lat[0], m_lat[1]), ffn_w_in[layer, 0], ffn_w_out[layer, 0])
        h_ctx = h_ctx + 0.5 * m_ctx[2] * swiglu(ada_pre(h_ctx, g0, m_ctx[0], m_ctx[1]), ffn_w_in[layer, 0], ffn_w_out[layer, 0])
        a_lat = ada_pre(h_lat, g1, m_lat[3], m_lat[4])
        a_ctx = ada_pre(h_ctx, g1, m_ctx[3], m_ctx[4])
        if layer % 2 == 0:
            e = layer // 2
            y_lat, y_ctx = fourier_gqa_mixer(a_lat, a_ctx, ab_w_in[e], qk_norm[e], ab_w_out[e], not last)
        else:
            o = layer // 2
            y_lat, y_ctx = hgrn2_mixer(a_lat, a_ctx, hgrn_w_in[o], lower_bounds[layer], hgrn_o_norm[o], hgrn_w_out[o], not last)
        h_lat = h_lat + m_lat[5] * y_lat
        h_lat = h_lat + 0.5 * m_lat[8] * swiglu(ada_pre(h_lat, g2, m_lat[6], m_lat[7]), ffn_w_in[layer, 1], ffn_w_out[layer, 1])
        if not last:
            h_ctx = h_ctx + m_ctx[5] * y_ctx
            h_ctx = h_ctx + 0.5 * m_ctx[8] * swiglu(ada_pre(h_ctx, g2, m_ctx[6], m_ctx[7]), ffn_w_in[layer, 1], ffn_w_out[layer, 1])
    return rms_norm(h_lat, final_norm)
```

```cpp
#include <hip/hip_runtime.h>
#include <hip/hip_bf16.h>
#include <cstdio>
#include <cstdint>
#ifndef MK_SPLIT
#define MK_SPLIT 0
#endif
namespace pg8 {
#define PG8_LAS __attribute__((address_space(3)))
typedef unsigned short bf16_t;
typedef short bf16x8 __attribute__((ext_vector_type(8)));
typedef float f32x4 __attribute__((ext_vector_type(4)));
typedef unsigned u32x4 __attribute__((ext_vector_type(4)));
constexpr int BM = 256, BK = 64, HALF = 128, HTB = HALF * BK * 2  , STAGE_BYTES = 8 * HTB, NXCD = 8, WGM = 8;
__host__ __device__ __forceinline__ int lds_byte(int r, int c) { const int st = (r >> 4) * 2 + (c >> 5), rr = r & 15, cc = c & 31, ob = rr * 64 + cc * 2; return st * 1024 + (ob ^ (((ob >> 9) & 1) << 5)); }
__host__ __device__ __forceinline__ void stage_rc(int b, int& R, int& C) { const int st = b / 1024, sb = b % 1024, swz = sb ^ (((sb >> 9) & 1) << 5); R = (st >> 1) * 16 + swz / 64; C = (st & 1) * 32 + (swz % 64) / 2; }
__host__ __device__ __forceinline__ int perm32(int rho) { const int n = rho >> 4, i = rho & 15; return 8 * (i >> 2) + 4 * n + (i & 3); }

struct Unit { int pm, pn, z, k0, nt; };
struct Gemm { const bf16_t* A; const bf16_t* Bt; int lda, ldb; size_t azs, bzs, kstA = 0, tstA = 0; };

constexpr int SB_ = 8448, PPB = 33;
struct StaticOrder {
    int nM, nN, nwg, G, c, ntk, latonly, wgm;
    __host__ __device__ void init(int M, int N, int K, int G_, int c_, int latonly_ = 0, int wgm_ = WGM) { nM = latonly_ ? 64 : M / BM; nN = N / BM; nwg = nM * nN; G = G_; c = c_; ntk = K / BK; latonly = latonly_; wgm = wgm_; }
    __host__ __device__ bool next(int i, Unit& u) const {
        const long L = (long)i * G + c; if (L >= nwg) return false;
#if defined(__HIP_DEVICE_COMPILE__)
        int nN = this->nN, nM = this->nM, nwg = this->nwg; asm volatile("" : "+s"(nN), "+s"(nM), "+s"(nwg));
#endif
        int wgid = (int)L; { const int q = nwg / NXCD, r = nwg % NXCD, xcd = wgid % NXCD, off = wgid / NXCD; wgid = (xcd < r ? xcd * (q + 1) : r * (q + 1) + (xcd - r) * q) + off; }
        const int nig = wgm * nN, gid = wgid / nig, fm = gid * wgm, gsz = (nM - fm) < wgm ? (nM - fm) : wgm;
        u.pm = fm + ((wgid % nig) % gsz); u.pn = (wgid % nig) / gsz; u.z = 0; u.k0 = 0; u.nt = ntk;
        if (latonly) u.pm += 1 + (u.pm >= 32 ? 1 : 0);
        return true;
    }
    __device__ __forceinline__ void a_ready(const Unit&) const {}
    __device__ __forceinline__ void done(const Unit&) const {}
};
struct ResidOrder {
    StaticOrder so; int nsl;
    __device__ bool next(int i, Unit& u) const {
        const int c = so.c, has = c < 16 * nsl, first = has && !(c & 1);
        if (first) { if (i == 0) { slab(c, u); return true; } return so.next(i - 1, u); }
        if (so.next(i, u)) return true;
        const long L = (long)i * so.G + c; if (has && L >= so.nwg && L - so.G < so.nwg) { slab(c, u); return true; }
        return false;
    }
    __device__ void slab(int L, Unit& u) const { const int tile = L & 15, sl = L >> 4; u.pm = (tile >> 3) * PPB; u.pn = tile & 7; u.z = 1; u.k0 = sl * 512; u.nt = 8; }
    __device__ __forceinline__ void a_ready(const Unit&) const {}
    __device__ __forceinline__ void done(const Unit&) const {}
};
struct DftOrder {
    int nM, nN, nz, G, c, ntk;
    __device__ bool next(int i, Unit& u) const {
        const int L = i * G + c; if (L >= nM * nN * nz) return false;
        const int per = nM * nN; u.z = L / per; const int r = L % per; u.pm = r / nN; u.pn = r % nN; u.k0 = 0; u.nt = ntk; return true;
    }
    __device__ __forceinline__ void a_ready(const Unit&) const {}
    __device__ __forceinline__ void done(const Unit&) const {}
};
__device__ __forceinline__ unsigned cvt_pk_bf16(float lo, float hi) { unsigned r; asm volatile("v_cvt_pk_bf16_f32 %0, %1, %2" : "=v"(r) : "v"(lo), "v"(hi)); return r; }
__device__ __forceinline__ float fast_sigmoid(float x) { return __builtin_amdgcn_rcpf(1.f + __builtin_amdgcn_exp2f(-1.4426950408889634f * x)); }

struct EpiSwiGLU {
    static constexpr bool PERM = true, AFTER_DRAIN = false;
    bf16_t* O; int ldc;
    __device__ __forceinline__ void operator()(const f32x4 (&acc)[2][2][4][2], const Unit& u, int wr, int wc, int fr, int fq) const {
        const int row0 = u.pm * BM + wr * 64 + fr, col0 = u.pn * HALF + wc * 32 + 8 * fq;
#pragma unroll
        for (int ai = 0; ai < 2; ++ai)
#pragma unroll
            for (int m = 0; m < 4; ++m) {
                float a[8], e[8];
#pragma unroll
                for (int q = 0; q < 8; ++q) a[q] = acc[ai][0][m][q >> 2][q & 3];
#pragma unroll
                for (int q = 0; q < 8; ++q) e[q] = __builtin_amdgcn_exp2f(-a[q]);
#pragma unroll
                for (int q = 0; q < 8; ++q) e[q] += 1.f;
#pragma unroll
                for (int q = 0; q < 8; ++q) e[q] = __builtin_amdgcn_rcpf(e[q]);
#pragma unroll
                for (int q = 0; q < 8; ++q) a[q] = a[q] * acc[ai][1][m][q >> 2][q & 3] * e[q];
                u32x4 w; w.x = cvt_pk_bf16(a[0], a[1]); w.y = cvt_pk_bf16(a[2], a[3]); w.z = cvt_pk_bf16(a[4], a[5]); w.w = cvt_pk_bf16(a[6], a[7]);
                const int row = row0 + ai * HALF + m * 16;
                *(u32x4*)(O + (((size_t)(row >> 8) * (ldc >> 6) + (col0 >> 6)) * 256 + (row & 255)) * 64 + (col0 & 63)) = w; }
    }
};
struct EpiResid {
    static constexpr bool PERM = true, AFTER_DRAIN = false;
    bf16_t* D; const float* gate; float coef; float* SLAB; int probe_rep;
    __device__ __forceinline__ void operator()(const f32x4 (&acc)[2][2][4][2], const Unit& u, int wr, int wc, int fr, int fq) const {
#ifdef PROBE_SKIP_EPI
        if (probe_rep) return;
#endif
        const int b = u.pm / PPB, pp = u.pm % PPB, mrow = pp == 0 ? 2 : b;
        const int rloc0 = wr * 64 + fr, col0 = u.pn * BM + wc * 32 + 8 * fq;
        if (u.z) {
            float* sp = SLAB + ((size_t)(u.k0 >> 9) * 512 + b * 256) * 2048;
#pragma unroll
            for (int ai = 0; ai < 2; ++ai)
#pragma unroll
                for (int m = 0; m < 4; ++m) { float* dp = sp + (size_t)(rloc0 + ai * HALF + m * 16) * 2048 + col0;
#pragma unroll
                    for (int bj = 0; bj < 2; ++bj)
#pragma unroll
                        for (int n = 0; n < 2; ++n) *(f32x4*)(dp + bj * HALF + 4 * n) = acc[ai][bj][m][n]; }
            return;
        }
        const float* gp = gate + (size_t)mrow * 18432 + col0;
        f32x4 gv[2][2];
#pragma unroll
        for (int bj = 0; bj < 2; ++bj)
#pragma unroll
            for (int n = 0; n < 2; ++n) gv[bj][n] = *(const f32x4*)(gp + bj * HALF + 4 * n) * coef;
        bf16_t* dbase = D + ((size_t)u.pm * BM + rloc0) * 2048 + col0;
#pragma unroll
        for (int ai = 0; ai < 2; ++ai)
#pragma unroll
            for (int m = 0; m < 4; ++m)
#pragma unroll
                for (int bj = 0; bj < 2; ++bj) { const f32x4 v0 = gv[bj][0] * acc[ai][bj][m][0], v1 = gv[bj][1] * acc[ai][bj][m][1];
                    u32x4 w; w.x = cvt_pk_bf16(v0[0], v0[1]); w.y = cvt_pk_bf16(v0[2], v0[3]); w.z = cvt_pk_bf16(v1[0], v1[1]); w.w = cvt_pk_bf16(v1[2], v1[3]);
                    *(u32x4*)(dbase + (size_t)(ai * HALF + m * 16) * 2048 + bj * HALF) = w; }
    }
};
struct ABOrder {
    StaticOrder so; int G, c;
    __device__ bool next(int i, Unit& u) const {
        if (so.next(i, u)) return true;
        const int L = i * G + c - so.nwg; if (L >= 4 * 66) return false;
        u.z = 1; u.pm = L & 3; u.pn = L >> 2; u.k0 = 0; u.nt = so.ntk; return true;
    }
    __device__ __forceinline__ void a_ready(const Unit&) const {}
    __device__ __forceinline__ void done(const Unit&) const {}
};
struct EpiAB {
    static constexpr bool PERM = true, AFTER_DRAIN = false;
    bf16_t *UWL, *UWC, *Q, *Kb, *Vb;
    __device__ __forceinline__ void operator()(const f32x4 (&acc)[2][2][4][2], const Unit& u, int wr, int wc, int fr, int fq) const {
        bf16_t* base; size_t ldc, bjs = HALF; int col0;
        if (u.z == 0) {
            if (u.pn < 6) { base = Q + (size_t)u.pm * BM * 1536; ldc = 1536; col0 = u.pn * BM + wc * 32 + 8 * fq; }
            else {
                const int b = u.pm / PPB, pp = u.pm % PPB, ct = (u.pn - 6) & 1;
                base = (u.pn < 8 ? Kb : Vb) + ((size_t)(b * 4 + ct * 2) * SB_ + (size_t)pp * 256) * 128; ldc = 128; bjs = (size_t)SB_ * 128; col0 = wc * 32 + 8 * fq; }
        } else {
            const int b = u.pn / PPB, pp = u.pn % PPB, part = u.pm >> 1;
            const size_t r0 = (size_t)part * 1024 + b * 512 + (u.pm & 1) * 256;
            if (pp == 0) { base = UWC + r0 * 256; ldc = 256; col0 = wc * 32 + 8 * fq; } else { base = UWL + r0 * 8192; ldc = 8192; col0 = (pp - 1) * 256 + wc * 32 + 8 * fq; }
        }
        const int rloc0 = wr * 64 + fr;
#pragma unroll
        for (int ai = 0; ai < 2; ++ai)
#pragma unroll
            for (int m = 0; m < 4; ++m) { bf16_t* rowp = base + (size_t)(rloc0 + ai * HALF + m * 16) * ldc + col0;
#pragma unroll
                for (int bj = 0; bj < 2; ++bj) { const f32x4 v0 = acc[ai][bj][m][0], v1 = acc[ai][bj][m][1];
                    u32x4 w; w.x = cvt_pk_bf16(v0[0], v0[1]); w.y = cvt_pk_bf16(v0[2], v0[3]); w.z = cvt_pk_bf16(v1[0], v1[1]); w.w = cvt_pk_bf16(v1[2], v1[3]);
                    *(u32x4*)(rowp + bj * bjs) = w; } }
    }
};
struct EpiDFT {
    static constexpr bool PERM = true, AFTER_DRAIN = false;
    bf16_t* MIX; float scale;
    __device__ __forceinline__ void operator()(const f32x4 (&acc)[2][2][4][2], const Unit& u, int wr, int wc, int fr, int fq) const {
        const int kap = u.pn >> 2, b = (u.pn >> 1) & 1, col0 = (u.pn & 1) * 256 + wc * 32 + 8 * fq;
#pragma unroll
        for (int ai = 0; ai < 2; ++ai)
#pragma unroll
            for (int m = 0; m < 4; ++m) { const int kp = u.pm * BM + wr * 64 + fr + ai * HALF + m * 16; bf16_t* rowp = MIX + ((size_t)b * SB_ + 256 + 8 * kp + kap) * 2048 + col0;
#pragma unroll
                for (int bj = 0; bj < 2; ++bj) { const f32x4 v0 = acc[ai][bj][m][0] * scale, v1 = acc[ai][bj][m][1] * scale;
                    u32x4 w; w.x = cvt_pk_bf16(v0[0], v0[1]); w.y = cvt_pk_bf16(v0[2], v0[3]); w.z = cvt_pk_bf16(v1[0], v1[1]); w.w = cvt_pk_bf16(v1[2], v1[3]);
                    *(u32x4*)(rowp + bj * HALF) = w; } }
    }
};
struct EpiHG {
    static constexpr bool PERM = true, AFTER_DRAIN = false;
    bf16_t* O; const float* lbl;
    __device__ __forceinline__ void operator()(const f32x4 (&acc)[2][2][4][2], const Unit& u, int wr, int wc, int fr, int fq) const {
        const int sec = u.pn >> 3, row0 = u.pm * BM + wr * 64 + fr, col0 = u.pn * BM + wc * 32 + 8 * fq, cs0 = (u.pn & 7) * BM + wc * 32 + 8 * fq;
        float lb[2][8];
        if (sec == 1 || sec == 2) {
#pragma unroll
            for (int bj = 0; bj < 2; ++bj)
#pragma unroll
                for (int e = 0; e < 8; ++e) { const int c = cs0 + bj * HALF + e; lb[bj][e] = fast_sigmoid(lbl[2048 + c] - lbl[c]); }
        }
#pragma unroll
        for (int ai = 0; ai < 2; ++ai)
#pragma unroll
            for (int m = 0; m < 4; ++m) { bf16_t* rowp = O + ((size_t)(u.pn * 2) * 16896 + (row0 + ai * HALF + m * 16)) * 128 + wc * 32 + 8 * fq;
#pragma unroll
                for (int bj = 0; bj < 2; ++bj) { float v[8];
#pragma unroll
                    for (int e = 0; e < 8; ++e) v[e] = acc[ai][bj][m][e >> 2][e & 3];
                    u32x4 w;
                    if (sec == 1 || sec == 2) { unsigned q[8];
#pragma unroll
                        for (int e = 0; e < 8; ++e) { const float f = lb[bj][e] + (1.f - lb[bj][e]) * fast_sigmoid(v[e]); float t = fminf(fmaxf(f * 65535.f, 0.f), 65535.f); q[e] = (unsigned)__builtin_rintf(t); }
                        w.x = q[0] | (q[1] << 16); w.y = q[2] | (q[3] << 16); w.z = q[4] | (q[5] << 16); w.w = q[6] | (q[7] << 16);
                    } else {
                        if (sec == 0) {
#pragma unroll
                            for (int e = 0; e < 8; ++e) v[e] = v[e] * fast_sigmoid(v[e]);
                        } else if (sec == 4) {
#pragma unroll
                            for (int e = 0; e < 8; ++e) v[e] = fast_sigmoid(v[e]);
                        }
                        w.x = cvt_pk_bf16(v[0], v[1]); w.y = cvt_pk_bf16(v[2], v[3]); w.z = cvt_pk_bf16(v[4], v[5]); w.w = cvt_pk_bf16(v[6], v[7]);
                    }
                    *(u32x4*)(rowp + (size_t)bj * 16896 * 128) = w; } }
    }
};
template <class Epi, class Sched, bool ALIGN_EPI = false, bool SP2 = false>
__device__ __forceinline__ void gemm_phase(PG8_LAS unsigned char* lds, const Gemm g, const Sched& S, const Epi& E) {
    int tid_o = threadIdx.x; asm volatile("" : "+v"(tid_o));
    const int tid = tid_o, wid = __builtin_amdgcn_readfirstlane(tid >> 6), lane = tid & 63, wr = wid >> 2, wc = wid & 3, fr = lane & 15, fq = lane >> 4;
    unsigned voffA[2], voffB[2];
#pragma unroll
    for (int i = 0; i < 2; ++i) { int R, C; stage_rc(tid * 16 + i * 8192, R, C); const int Rb = Epi::PERM ? ((R & ~31) + perm32(R & 31)) : R;
        voffA[i] = (unsigned)(R * g.lda + C) * 2u; voffB[i] = (unsigned)(Rb * g.ldb + C) * 2u; }
    const size_t kstep = (size_t)(BK * 2);
    const size_t kstA = g.kstA ? g.kstA : kstep;
    const size_t hstepA = (size_t)HALF * g.lda * 2, hstepB = (size_t)HALF * g.ldb * 2;
    const size_t tstepA = g.tstA ? g.tstA : 2 * hstepA, tstepB = 2 * hstepB;
    const unsigned ldsw = (unsigned)wid * 1024u;
    const int aoff = lds_byte(wr * 64 + fr, fq * 8), boff = lds_byte(wc * 32 + fr, fq * 8);
#define PG8_SA(b, h) (((b) * 2 + (h)) * HTB)
#define PG8_SB(b, h) ((4 + (b) * 2 + (h)) * HTB)
#define PG8_STAGE(bufoff, gbase, voff) do { _Pragma("unroll") for (int _i = 0; _i < 2; ++_i) \
        __builtin_amdgcn_global_load_lds((const unsigned*)((const char*)(gbase) + (voff)[_i]), (PG8_LAS unsigned*)(lds + (bufoff) + ldsw + _i * 8192), 16, 0, 0); } while (0)
#define PG8_LDA(dst, b, h) do { _Pragma("unroll") for (int m = 0; m < 4; ++m) _Pragma("unroll") for (int k = 0; k < 2; ++k) dst[m][k] = *(const PG8_LAS bf16x8*)(lds + PG8_SA(b, h) + aoff + m * 2048 + k * 1024); } while (0)
#define PG8_LDB(dst, b, h) do { _Pragma("unroll") for (int n = 0; n < 2; ++n) _Pragma("unroll") for (int k = 0; k < 2; ++k) dst[n][k] = *(const PG8_LAS bf16x8*)(lds + PG8_SB(b, h) + boff + n * 2048 + k * 1024); } while (0)
#define PG8_MMA(ai, bj, At, Bt) do { __builtin_amdgcn_s_setprio(1); _Pragma("unroll") for (int m = 0; m < 4; ++m) _Pragma("unroll") for (int n = 0; n < 2; ++n) _Pragma("unroll") for (int k = 0; k < 2; ++k) \
        acc[ai][bj][m][n] = __builtin_amdgcn_mfma_f32_16x16x32_bf16(Bt[n][k], At[m][k], acc[ai][bj][m][n], 0, 0, 0); __builtin_amdgcn_s_setprio(0); } while (0)
#define PG8_WAIT_V(n) asm volatile("s_waitcnt vmcnt(" #n ")" ::: "memory")
#define PG8_WAIT_L(n) asm volatile("s_waitcnt lgkmcnt(" #n ")" ::: "memory")
#define PG8_BAR __builtin_amdgcn_s_barrier()
#define PG8_SCHED __builtin_amdgcn_sched_barrier(0)
    Unit cur, nxt; int ui = 0;
    if (!S.next(0, cur)) return;
    f32x4 acc[2][2][4][2];
#pragma unroll
    for (int a = 0; a < 2; ++a)
#pragma unroll
        for (int b = 0; b < 2; ++b)
#pragma unroll
            for (int m = 0; m < 4; ++m)
#pragma unroll
                for (int n = 0; n < 2; ++n) acc[a][b][m][n] = (f32x4){0.f, 0.f, 0.f, 0.f};
    bf16x8 At[4][2], B0[2][2], B1[2][2];
    const char* cA = (const char*)g.A + (size_t)cur.pm * tstepA + (size_t)cur.z * g.azs + (size_t)(cur.k0 >> 6) * kstA; const char* cB = (const char*)g.Bt + (size_t)cur.pn * tstepB + (size_t)cur.z * g.bzs + (size_t)cur.k0 * 2;
    S.a_ready(cur);
    if constexpr (SP2) {
        PG8_STAGE(PG8_SB(0, 0), cB, voffB); PG8_STAGE(PG8_SB(0, 1), cB + hstepB, voffB); PG8_STAGE(PG8_SA(0, 0), cA, voffA); PG8_STAGE(PG8_SA(0, 1), cA + hstepA, voffA);
        if (wr == 1) PG8_BAR;
        PG8_WAIT_V(2); PG8_BAR;
        PG8_STAGE(PG8_SB(1, 0), cB + kstep, voffB); PG8_STAGE(PG8_SA(1, 0), cA + kstA, voffA); PG8_STAGE(PG8_SB(1, 1), cB + hstepB + kstep, voffB);
        PG8_WAIT_V(6); PG8_BAR;
    } else {
        PG8_STAGE(PG8_SB(0, 0), cB, voffB); PG8_STAGE(PG8_SA(0, 0), cA, voffA); PG8_STAGE(PG8_SB(0, 1), cB + hstepB, voffB); PG8_STAGE(PG8_SA(0, 1), cA + hstepA, voffA);
        if (wr == 1) PG8_BAR;
        PG8_WAIT_V(4); PG8_BAR;
        PG8_STAGE(PG8_SB(1, 0), cB + kstep, voffB); PG8_STAGE(PG8_SA(1, 0), cA + kstA, voffA); PG8_STAGE(PG8_SB(1, 1), cB + hstepB + kstep, voffB);
        PG8_WAIT_V(6); PG8_BAR;
    }
    for (;;) {
        const bool has_next = S.next(ui + 1, nxt);
        const char* nA = has_next ? (const char*)g.A + (size_t)nxt.pm * tstepA + (size_t)nxt.z * g.azs + (size_t)(nxt.k0 >> 6) * kstA : cA; const char* nB = has_next ? (const char*)g.Bt + (size_t)nxt.pn * tstepB + (size_t)nxt.z * g.bzs + (size_t)nxt.k0 * 2 : cB;
        const int nt = cur.nt;
        for (int t = 0; t < nt; t += 2) {
            const bool last = (t == nt - 2);
            const char* a1 = cA + (size_t)(t + 1) * kstA;
            const char* a2 = last ? nA : cA + (size_t)(t + 2) * kstA; const char* b2 = last ? nB : cB + (size_t)(t + 2) * kstep;
            const char* a3 = a2 + kstA; const char* b3 = b2 + kstep;
            if (last && has_next) S.a_ready(nxt);
            if constexpr (SP2) {
            PG8_LDB(B0, 0, 0); PG8_LDB(B1, 0, 1); PG8_SCHED; PG8_LDA(At, 0, 0); PG8_STAGE(PG8_SA(1, 1), a1 + hstepA, voffA);
            PG8_WAIT_V(8); PG8_WAIT_L(0); PG8_BAR; PG8_MMA(0, 0, At, B0); PG8_MMA(0, 1, At, B1); PG8_BAR; PG8_SCHED;
            PG8_LDA(At, 0, 1); PG8_STAGE(PG8_SB(0, 0), b2, voffB); PG8_STAGE(PG8_SB(0, 1), b2 + hstepB, voffB); PG8_STAGE(PG8_SA(0, 0), a2, voffA);
            PG8_WAIT_V(8); PG8_WAIT_L(0); PG8_BAR; PG8_MMA(1, 0, At, B0); PG8_MMA(1, 1, At, B1); PG8_BAR; PG8_SCHED;
            PG8_LDB(B0, 1, 0); PG8_LDB(B1, 1, 1); PG8_SCHED; PG8_LDA(At, 1, 0); PG8_STAGE(PG8_SA(0, 1), a2 + hstepA, voffA);
            PG8_WAIT_V(8); PG8_WAIT_L(0); PG8_BAR; PG8_MMA(0, 0, At, B0); PG8_MMA(0, 1, At, B1); PG8_BAR; PG8_SCHED;
            PG8_LDA(At, 1, 1); PG8_STAGE(PG8_SB(1, 0), b3, voffB); PG8_STAGE(PG8_SB(1, 1), b3 + hstepB, voffB); PG8_STAGE(PG8_SA(1, 0), a3, voffA);
            PG8_WAIT_V(8); PG8_WAIT_L(0); PG8_BAR; PG8_MMA(1, 0, At, B0); PG8_MMA(1, 1, At, B1); PG8_BAR; PG8_SCHED;
            } else {
            PG8_LDB(B0, 0, 0); PG8_SCHED; PG8_LDA(At, 0, 0); PG8_STAGE(PG8_SA(1, 1), a1 + hstepA, voffA);
            PG8_WAIT_L(8); PG8_BAR; PG8_WAIT_L(0); PG8_MMA(0, 0, At, B0); PG8_BAR; PG8_SCHED;
            PG8_LDB(B1, 0, 1); PG8_STAGE(PG8_SB(0, 0), b2, voffB);
            PG8_BAR; PG8_WAIT_L(0); PG8_MMA(0, 1, At, B1); PG8_BAR;
            PG8_LDA(At, 0, 1); PG8_STAGE(PG8_SA(0, 0), a2, voffA);
            PG8_BAR; PG8_WAIT_L(0); PG8_MMA(1, 0, At, B0); PG8_BAR; PG8_SCHED;
            PG8_STAGE(PG8_SB(0, 1), b2 + hstepB, voffB);
            PG8_WAIT_V(6); PG8_BAR; PG8_MMA(1, 1, At, B1); PG8_BAR;
            PG8_LDB(B0, 1, 0); PG8_SCHED; PG8_LDA(At, 1, 0); PG8_STAGE(PG8_SA(0, 1), a2 + hstepA, voffA);
            PG8_WAIT_L(8); PG8_BAR; PG8_WAIT_L(0); PG8_MMA(0, 0, At, B0); PG8_BAR; PG8_SCHED;
            PG8_LDB(B1, 1, 1); PG8_STAGE(PG8_SB(1, 0), b3, voffB);
            PG8_BAR; PG8_WAIT_L(0); PG8_MMA(0, 1, At, B1); PG8_BAR;
            PG8_LDA(At, 1, 1); PG8_STAGE(PG8_SA(1, 0), a3, voffA);
            PG8_BAR; PG8_WAIT_L(0); PG8_MMA(1, 0, At, B0); PG8_BAR; PG8_SCHED;
            PG8_STAGE(PG8_SB(1, 1), b3 + hstepB, voffB);
            PG8_WAIT_V(6); PG8_BAR; PG8_MMA(1, 1, At, B1); PG8_BAR;
            }
        }
        if constexpr (ALIGN_EPI) { if (wr == 0) PG8_BAR; }
        if constexpr (!Epi::AFTER_DRAIN) { E(acc, cur, wr, wc, fr, fq); S.done(cur); }
        if (!has_next) break;
#pragma unroll
        for (int a = 0; a < 2; ++a)
#pragma unroll
            for (int b = 0; b < 2; ++b)
#pragma unroll
                for (int m = 0; m < 4; ++m)
#pragma unroll
                    for (int n = 0; n < 2; ++n) acc[a][b][m][n] = (f32x4){0.f, 0.f, 0.f, 0.f};
        cur = nxt; cA = nA; cB = nB; ++ui;
        if constexpr (ALIGN_EPI) { if (wr == 1) PG8_BAR; }
    }
    PG8_WAIT_V(0);
    if constexpr (!ALIGN_EPI) { if (wr == 0) PG8_BAR; }
    PG8_BAR;
    if constexpr (Epi::AFTER_DRAIN) { E.fused(acc, cur, wr, wc, fr, fq, lds, wid, lane); S.done(cur); }
#undef PG8_SA
#undef PG8_SB
#undef PG8_STAGE
#undef PG8_LDA
#undef PG8_LDB
#undef PG8_MMA
#undef PG8_WAIT_V
#undef PG8_WAIT_L
#undef PG8_BAR
#undef PG8_SCHED
}
}
namespace attn {
using bf16 = __hip_bfloat16;
constexpr int   D = 128, NW = 8, QBLK = 32, KVBLK = 64;
constexpr float SCALE = 0.088388347648318440f;
constexpr float THR = 8.f;
constexpr int SDEPTH = 2;
constexpr int LDQ = 1536, LDK = 128, LDO = 2048;
constexpr size_t SHM_V = KVBLK * D * 2, SHM_K = KVBLK * D * 2, SHM_ATTN = 2 * SHM_V + 2 * SHM_K + NW * 64 * 4;
using bf16x8 = __attribute__((ext_vector_type(8))) short;
using s16x4  = __attribute__((ext_vector_type(4))) short;
using f32x16 = __attribute__((ext_vector_type(16))) float;
using f32x8  = __attribute__((ext_vector_type(8))) float;
using f32x4v = __attribute__((ext_vector_type(4))) float;
using u32x4  = __attribute__((ext_vector_type(4))) unsigned;
#define KSWZ(row, colB) ((row) * 256 + ((colB) ^ (((row) & 7) << 4)))
#define SBAR() __builtin_amdgcn_sched_barrier(0)
__device__ __forceinline__ int crow(int r, int hi) { return (r & 3) + 8 * (r >> 2) + 4 * hi; }
__device__ __forceinline__ unsigned cvtpk(float lo, float hi) {
  unsigned r; asm volatile("v_cvt_pk_bf16_f32 %0, %1, %2" : "=v"(r) : "v"(lo), "v"(hi)); return r;
}
template <typename TIn> struct Stage;
template <> struct Stage<bf16>  { using T = bf16x8;
  __device__ static __forceinline__ T ld8(const bf16* p) { return *reinterpret_cast<const bf16x8*>(p); }
  __device__ static __forceinline__ bf16x8 tobf(T x) { return x; } };
template <> struct Stage<float> { using T = f32x8;
  __device__ static __forceinline__ T ld8(const float* p) { return *reinterpret_cast<const f32x8*>(p); }
  __device__ static __forceinline__ bf16x8 tobf(T x) {
    u32x4 w = {cvtpk(x[0], x[1]), cvtpk(x[2], x[3]), cvtpk(x[4], x[5]), cvtpk(x[6], x[7])}; return *reinterpret_cast<bf16x8*>(&w); } };

__device__ __forceinline__ void partialSM(f32x16& p0, f32x16& p1, float& m_reg, float& mn, float& alpha) {
  constexpr float C = SCALE * 1.4426950408889634f;
  float pmax = p0[0]; for (int r = 1; r < 16; ++r) pmax = fmaxf(pmax, p0[r]); for (int r = 0; r < 16; ++r) pmax = fmaxf(pmax, p1[r]);
  { auto rr = __builtin_amdgcn_permlane32_swap(__float_as_uint(pmax), __float_as_uint(pmax), false, false);
    pmax = fmaxf(__uint_as_float(rr[0]), __uint_as_float(rr[1])); }
  if (__builtin_expect(__all(pmax - m_reg <= THR / SCALE), 1)) { mn = m_reg; alpha = 1.f; }
  else { mn = fmaxf(m_reg, pmax); alpha = __builtin_amdgcn_exp2f((m_reg - mn) * C); m_reg = mn; }
  float mnC = -mn * C;
  for (int r = 0; r < 16; ++r) p0[r] = fmaf(p0[r], C, mnC); for (int r = 0; r < 16; ++r) p1[r] = fmaf(p1[r], C, mnC);
  for (int r = 0; r < 16; ++r) p0[r] = __builtin_amdgcn_exp2f(p0[r]);
}
__device__ __forceinline__ void finishSM(f32x16& p0, f32x16& p1, float alpha, float& l_reg, bf16x8& pa0, bf16x8& pa1, bf16x8& pa2, bf16x8& pa3) {
  for (int r = 0; r < 16; ++r) p1[r] = __builtin_amdgcn_exp2f(p1[r]);
  float ps = 0; for (int r = 0; r < 16; ++r) ps += p0[r]; for (int r = 0; r < 16; ++r) ps += p1[r];
  { auto rr = __builtin_amdgcn_permlane32_swap(__float_as_uint(ps), __float_as_uint(ps), false, false);
    ps = __uint_as_float(rr[0]) + __uint_as_float(rr[1]); }
  l_reg = l_reg * alpha + ps;
#define PK4(P, BASE, OUT) do { unsigned a0 = cvtpk(P[BASE + 0], P[BASE + 1]), a1 = cvtpk(P[BASE + 2], P[BASE + 3]);   \
    unsigned b0 = cvtpk(P[BASE + 4], P[BASE + 5]), b1 = cvtpk(P[BASE + 6], P[BASE + 7]);                              \
    auto r0 = __builtin_amdgcn_permlane32_swap(a0, b0, false, false); auto r1 = __builtin_amdgcn_permlane32_swap(a1, b1, false, false); \
    u32x4 w = {r0[0], r1[0], r0[1], r1[1]}; OUT = *reinterpret_cast<bf16x8*>(&w); } while (0)
  PK4(p0, 0, pa0); PK4(p0, 8, pa1); PK4(p1, 0, pa2); PK4(p1, 8, pa3);
#undef PK4
}
__device__ __forceinline__ void qkt(f32x16& p0, f32x16& p1, const bf16* Ks, const bf16x8* qr, int r32, int hi) {
  p0 = f32x16{}; p1 = f32x16{};
  for (int d0 = 0; d0 < 8; ++d0) { int cb = (d0 * 16 + hi * 8) * 2;
    bf16x8 b0 = *reinterpret_cast<const bf16x8*>((const char*)Ks + KSWZ(r32, cb));
    bf16x8 b1 = *reinterpret_cast<const bf16x8*>((const char*)Ks + KSWZ(32 + r32, cb));
    p0 = __builtin_amdgcn_mfma_f32_32x32x16_bf16(b0, qr[d0], p0, 0, 0, 0);
    p1 = __builtin_amdgcn_mfma_f32_32x32x16_bf16(b1, qr[d0], p1, 0, 0, 0); }
}
__device__ __forceinline__ int v_st(int k, int c) { const int kk = (k & ~0xC) | ((k & 4) << 1) | ((k & 8) >> 1); return ((kk >> 3) * 4 + (c >> 5)) * 512 + ((kk & 7) * 32 + (c & 31)) * 2; }
__device__ __forceinline__ int v_rd_base(int lane) { return ((lane & 3) << 3) | (((lane >> 2) & 3) << 6) | (((lane >> 4) & 1) << 5) | (((lane >> 5) & 1) << 8); }
constexpr int v_rd_off(int d0, int ks, int half) { return d0 * 512 + ks * 4096 + half * 2048; }
template <int OFF> __device__ __forceinline__ s16x4 tr_read(int vb) {
  s16x4 r; asm volatile("ds_read_b64_tr_b16 %0, %1 offset:%2" : "=&v"(r) : "v"(vb), "i"(OFF) : "memory"); return r;
}
template <int D0> __device__ __forceinline__ void pv_one(f32x16& od, int vb, bf16x8 pa0, bf16x8 pa1, bf16x8 pa2, bf16x8 pa3) {
  const s16x4 l0 = tr_read<v_rd_off(D0, 0, 0)>(vb), h0 = tr_read<v_rd_off(D0, 0, 1)>(vb), l1 = tr_read<v_rd_off(D0, 1, 0)>(vb), h1 = tr_read<v_rd_off(D0, 1, 1)>(vb);
  const s16x4 l2 = tr_read<v_rd_off(D0, 2, 0)>(vb), h2 = tr_read<v_rd_off(D0, 2, 1)>(vb), l3 = tr_read<v_rd_off(D0, 3, 0)>(vb), h3 = tr_read<v_rd_off(D0, 3, 1)>(vb);
  asm volatile("s_waitcnt lgkmcnt(0)" ::: "memory"); SBAR();
#define PK(L, H) (bf16x8){L[0], L[1], L[2], L[3], H[0], H[1], H[2], H[3]}
  od = __builtin_amdgcn_mfma_f32_32x32x16_bf16(pa0, PK(l0, h0), od, 0, 0, 0);
  od = __builtin_amdgcn_mfma_f32_32x32x16_bf16(pa1, PK(l1, h1), od, 0, 0, 0);
  od = __builtin_amdgcn_mfma_f32_32x32x16_bf16(pa2, PK(l2, h2), od, 0, 0, 0);
  od = __builtin_amdgcn_mfma_f32_32x32x16_bf16(pa3, PK(l3, h3), od, 0, 0, 0);
#undef PK
}
__device__ __forceinline__ void pv_d0(f32x16* o, int vb, bf16x8 pa0, bf16x8 pa1, bf16x8 pa2, bf16x8 pa3) {
  pv_one<0>(o[0], vb, pa0, pa1, pa2, pa3); pv_one<1>(o[1], vb, pa0, pa1, pa2, pa3); pv_one<2>(o[2], vb, pa0, pa1, pa2, pa3); pv_one<3>(o[3], vb, pa0, pa1, pa2, pa3);
}

template <typename TQ>
__device__ __forceinline__ void attn_dense_body(const TQ* __restrict__ Qb, const bf16* __restrict__ Kh, const bf16* __restrict__ Vh,
                                                unsigned short* __restrict__ Ob, int seq, char* lds, const float* __restrict__ qgain, const float* __restrict__ rope_blk) {
  using St = Stage<bf16>; using SQ = Stage<TQ>;
  int tid_o = threadIdx.x; asm volatile("" : "+v"(tid_o));
  const int tid = tid_o, wid = tid >> 6, lane = tid & 63, r32 = lane & 31, hi = lane >> 5;
  bf16* V_lds = (bf16*)lds; bf16* K_lds = (bf16*)(lds + 2 * SHM_V);
  float* ws = (float*)(lds + 2 * SHM_V + 2 * SHM_K) + wid * 64; float* li_l = ws; float* al_l = ws + 32;
  float m_reg = -1e30f, l_reg = 0; f32x16 o[4] = {}; bf16x8 qr[8];
  const TQ* Qw = Qb + (long)(wid * QBLK + r32) * LDQ + hi * 8;
  {
    float x[8][8]; float ss = 0.f;
#pragma unroll
    for (int d0 = 0; d0 < 8; ++d0) { const u32x4 raw = *reinterpret_cast<const u32x4*>(Qw + d0 * 16);
#pragma unroll
      for (int q = 0; q < 4; ++q) { x[d0][2 * q] = __uint_as_float(raw[q] << 16); x[d0][2 * q + 1] = __uint_as_float(raw[q] & 0xffff0000u); } }
#pragma unroll
    for (int d0 = 0; d0 < 8; ++d0)
#pragma unroll
      for (int e = 0; e < 8; ++e) ss += x[d0][e] * x[d0][e];
    ss += __shfl_xor(ss, 32);
    const float rs = 1.f / sqrtf(ss * (1.f / 128.f) + 1e-6f);
#pragma unroll
    for (int d0 = 0; d0 < 8; ++d0) { const float* gp = qgain + 16 * d0 + 8 * hi; const f32x8 g = *reinterpret_cast<const f32x8*>(gp);
#pragma unroll
      for (int e = 0; e < 8; ++e) x[d0][e] *= rs * g[e]; }
    if (rope_blk) {
      const float* rp = rope_blk + (long)(wid * QBLK + r32) * 128;
#pragma unroll
      for (int a = 0; a < 2; ++a)
#pragma unroll
        for (int dd = 0; dd < 2; ++dd) { const float* cp = rp + 2 * (a * 32 + 16 * dd + 8 * hi);
#pragma unroll
          for (int e4 = 0; e4 < 4; ++e4) { const f32x4v cs = *reinterpret_cast<const f32x4v*>(cp + 4 * e4);
#pragma unroll
            for (int u = 0; u < 2; ++u) { const int e = 2 * e4 + u; const float c = cs[2 * u], sn = cs[2 * u + 1], x1 = x[4 * a + dd][e], x2 = x[4 * a + 2 + dd][e];
              x[4 * a + dd][e] = x1 * c - x2 * sn; x[4 * a + 2 + dd][e] = x1 * sn + x2 * c; } } }
    }
#pragma unroll
    for (int d0 = 0; d0 < 8; ++d0) { u32x4 w = {cvtpk(x[d0][0], x[d0][1]), cvtpk(x[d0][2], x[d0][3]), cvtpk(x[d0][4], x[d0][5]), cvtpk(x[d0][6], x[d0][7])}; qr[d0] = *reinterpret_cast<bf16x8*>(&w); }
  }
  const int sr = tid >> 4, sc = (tid & 15) * 8, vst0 = v_st(sr, sc), vst1 = v_st(32 + sr, sc);
  const int vb0 = (int)(uintptr_t)V_lds + v_rd_base(lane);
  struct { typename St::T vs0, vs1, ks0, ks1; } sr_[SDEPTH];
#define SLOAD(i, k0) do { sr_[i].vs0 = St::ld8(&Vh[(long)((k0) + sr) * LDK + sc]); sr_[i].vs1 = St::ld8(&Vh[(long)((k0) + 32 + sr) * LDK + sc]); \
    sr_[i].ks0 = St::ld8(&Kh[(long)((k0) + sr) * LDK + sc]); sr_[i].ks1 = St::ld8(&Kh[(long)((k0) + 32 + sr) * LDK + sc]); } while (0)
#define SWRITE(b, i) do { *(bf16x8*)((char*)V_lds + (b) * SHM_V + vst0) = St::tobf(sr_[i].vs0);          \
    *(bf16x8*)((char*)V_lds + (b) * SHM_V + vst1) = St::tobf(sr_[i].vs1); int kc = sc * 2;               \
    *(bf16x8*)((char*)K_lds + (b) * SHM_K + KSWZ(sr, kc)) = St::tobf(sr_[i].ks0);                       \
    *(bf16x8*)((char*)K_lds + (b) * SHM_K + KSWZ(32 + sr, kc)) = St::tobf(sr_[i].ks1); } while (0)
#define SWAIT() do { if constexpr (SDEPTH == 2) asm volatile("s_waitcnt vmcnt(4)" ::: "memory"); else asm volatile("s_waitcnt vmcnt(0)" ::: "memory"); } while (0)
#define RESC(a) do { if (__any((a) < 1.f)) { if (hi == 0) al_l[r32] = (a); asm volatile("s_waitcnt lgkmcnt(0)" ::: "memory"); \
    for (int d = 0; d < 4; ++d) for (int r = 0; r < 16; ++r) o[d][r] *= al_l[crow(r, hi)]; } } while (0)
  f32x16 pA0, pA1, pB0, pB1; float mnA, mnB, alA, alB; bf16x8 pa0, pa1, pa2, pa3; const int NT = seq / KVBLK;
  constexpr int SE = 0, SO = SDEPTH - 1;
  SLOAD(SE, 0); asm volatile("s_waitcnt vmcnt(0)" ::: "memory"); SWRITE(0, SE); __syncthreads();
  qkt(pA0, pA1, K_lds, qr, r32, hi); partialSM(pA0, pA1, m_reg, mnA, alA);
  SLOAD(SO, KVBLK); if constexpr (SDEPTH == 2) { if (2 < NT) SLOAD(SE, 2 * KVBLK); }
  SWAIT(); SWRITE(1, SO); __syncthreads();
  for (int j = 1; j + 1 < NT; j += 2) {
    SBAR(); qkt(pB0, pB1, (bf16*)((char*)K_lds + SHM_K), qr, r32, hi);
    finishSM(pA0, pA1, alA, l_reg, pa0, pa1, pa2, pa3); SBAR();
    SLOAD(SO, (j + SDEPTH) * KVBLK); SBAR();
    pv_d0(o, vb0, pa0, pa1, pa2, pa3); partialSM(pB0, pB1, m_reg, mnB, alB);
    __syncthreads(); SWAIT(); SWRITE(0, SE);
    RESC(alB); __syncthreads();
    SBAR(); qkt(pA0, pA1, K_lds, qr, r32, hi);
    finishSM(pB0, pB1, alB, l_reg, pa0, pa1, pa2, pa3); SBAR();
    if (SDEPTH == 1 || j + 3 < NT) SLOAD(SE, (j + 1 + SDEPTH) * KVBLK); SBAR();
    pv_d0(o, vb0 + (int)SHM_V, pa0, pa1, pa2, pa3); partialSM(pA0, pA1, m_reg, mnA, alA);
    __syncthreads(); SWAIT(); SWRITE(1, SO);
    RESC(alA); __syncthreads();
  }
  SBAR(); qkt(pB0, pB1, (bf16*)((char*)K_lds + SHM_K), qr, r32, hi);
  finishSM(pA0, pA1, alA, l_reg, pa0, pa1, pa2, pa3); SBAR();
  pv_d0(o, vb0, pa0, pa1, pa2, pa3); partialSM(pB0, pB1, m_reg, mnB, alB);
  __syncthreads(); RESC(alB);
  finishSM(pB0, pB1, alB, l_reg, pa0, pa1, pa2, pa3); SBAR();
  pv_d0(o, vb0 + (int)SHM_V, pa0, pa1, pa2, pa3);
  if (hi == 0) li_l[r32] = l_reg; asm volatile("s_waitcnt lgkmcnt(0)" ::: "memory");
  float rli[16];
#pragma unroll
  for (int r = 0; r < 16; ++r) rli[r] = __builtin_amdgcn_rcpf(li_l[crow(r, hi)]);
  unsigned short* Ow = Ob + (long)(wid * QBLK) * LDO;
#pragma unroll
  for (int r = 0; r < 16; ++r) { int orow = crow(r, hi);
    for (int d0 = 0; d0 < 4; ++d0) Ow[(long)orow * LDO + d0 * 32 + r32] = (unsigned short)cvtpk(o[d0][r] * rli[r], 0.f); }
#undef SLOAD
#undef SWRITE
#undef SWAIT
#undef RESC
}

}
#define GAS __attribute__((address_space(1)))
#define LAS __attribute__((address_space(3)))
typedef unsigned short bf16;
typedef unsigned v4u __attribute__((ext_vector_type(4)));
typedef unsigned v2u __attribute__((ext_vector_type(2)));
typedef float f32x4 __attribute__((ext_vector_type(4)));
typedef float f32x2 __attribute__((ext_vector_type(2)));
typedef float f32x16 __attribute__((ext_vector_type(16)));
typedef short bf16x8 __attribute__((ext_vector_type(8)));
typedef short s16x4 __attribute__((ext_vector_type(4)));
typedef GAS unsigned gu32;
#define RLX_AGENT __ATOMIC_RELAXED, __HIP_MEMORY_SCOPE_AGENT
#define LDS_WAIT() asm volatile("s_waitcnt lgkmcnt(0)" ::: "memory")
#define VM_WAIT() asm volatile("s_waitcnt vmcnt(0)" ::: "memory")

constexpr int DM = 2048, NBATCH = 2, SEQ = 8192, CTXL = 256, SB = SEQ + CTXL, MALL = NBATCH * SB, FFD = 5632, PPB = 33;
constexpr int NWAVES = 8, NPH = 26;
constexpr float EPS = 1e-6f, LOG2E = 1.4426950408889634f;
static_assert(SB == pg8::SB_ && PPB == pg8::PPB, "row order constants");
constexpr size_t MiB = 1u << 20;
constexpr size_t WS_CTL = 0, CTL_ZERO_BYTES = 1 * MiB;
constexpr size_t WS_MOD = 1 * MiB;
constexpr size_t WS_ROPE = 2 * MiB;
constexpr size_t WS_DFT256 = 6 * MiB;
constexpr size_t WS_WFIN = 8 * MiB;
constexpr size_t WS_WFOUT = 184 * MiB;
constexpr size_t WS_WABIN = 272 * MiB;
constexpr size_t WS_WABOUT = 286 * MiB;
constexpr size_t WS_WHGIN = 296 * MiB;
constexpr size_t WS_WHGOUT = 336 * MiB;
constexpr size_t WS_H = 344 * MiB;
constexpr size_t WS_XN = 476 * MiB;
constexpr size_t WS_HID = 542 * MiB;
constexpr size_t WS_USEG = WS_HID, WS_DSEG = WS_HID + 134 * MiB;
constexpr size_t WS_OV = 724 * MiB;
constexpr size_t WS_DFT = WS_OV, WS_DFTA = WS_OV + 64 * MiB, WS_UWL = WS_OV + 256 * MiB, WS_UWC = WS_OV + 288 * MiB, WS_QB = WS_OV + 289 * MiB, WS_KB = WS_OV + 339 * MiB, WS_VB = WS_OV + 356 * MiB, WS_MIX = WS_OV + 373 * MiB;
constexpr size_t WS_HG = WS_OV, WS_OFW = WS_OV + 330 * MiB, WS_OBW = WS_OV + 396 * MiB;
constexpr size_t WS_SLAB = WS_OV + 462 * MiB;
constexpr size_t WS_DLT = WS_SLAB + 44 * MiB;
constexpr size_t WS_END = WS_DLT + 66 * MiB;
static_assert(WS_MIX + (size_t)MALL * 2048 * 2 <= WS_END && WS_OBW + (size_t)MALL * 2048 * 2 <= WS_END && WS_HID + (size_t)MALL * FFD * 2 <= WS_OV && WS_DSEG + 2112 * 128 * 4 <= WS_OV, "ws map");
static_assert(WS_WFIN + 4ull * 11264 * 2048 * 2 <= WS_WFOUT && WS_WFOUT + 4ull * 2048 * 5632 * 2 <= WS_WABIN && WS_H + (size_t)MALL * 2048 * 4 <= WS_XN && WS_XN + (size_t)MALL * 2048 * 2 <= WS_HID, "ws map 2");
constexpr int CW_BAR = 4096;
constexpr int CW_QHEAD = 64;
constexpr int LDS_BYTES = 163840, MISC_OFF = LDS_BYTES - 256;
static_assert(pg8::STAGE_BYTES <= MISC_OFF, "LDS map");

__device__ __forceinline__ unsigned f2bf(float f) { unsigned u = __builtin_bit_cast(unsigned, f); return (u + 0x7fffu + ((u >> 16) & 1u)) >> 16; }
__device__ __forceinline__ unsigned pk2(float lo, float hi) { return pg8::cvt_pk_bf16(lo, hi); }
__device__ __forceinline__ float bf2f(unsigned x) { return __builtin_bit_cast(float, x << 16); }
__device__ __forceinline__ float exp_f(float x) { return __builtin_amdgcn_exp2f(x * LOG2E); }
__device__ __forceinline__ float wave_sum(float v) {
#pragma unroll
    for (int o = 1; o < 64; o <<= 1) v += __shfl_xor(v, o);
    return v;
}
#define XB_TMO      128
#define XB_XCNT(j)  (256  + 64 * (j))
#define XB_XSUB(j)  (1280 + 64 * (j))
#define XB_XGEN(j)  (2304 + 64 * (j))
#define XB_TOP      3328
#define XB_TOPGEN   3392
#define XCD_BAR_WORDS 3456
#define XB_SPIN_CAP (1u << 18)

__device__ __forceinline__ unsigned xb_ld(unsigned* p)              { return __hip_atomic_load(p, __ATOMIC_RELAXED, __HIP_MEMORY_SCOPE_AGENT); }
__device__ __forceinline__ unsigned xb_add(unsigned* p, unsigned v) { return __hip_atomic_fetch_add(p, v, __ATOMIC_RELAXED, __HIP_MEMORY_SCOPE_AGENT); }
__device__ __forceinline__ unsigned xb_xcc_id() { return (unsigned)__builtin_amdgcn_s_getreg((3 << 11) | 20) & 0xFu; }
#define XB_SPIN(cond, bar) do { unsigned _sp = 0; while (cond) { __builtin_amdgcn_s_sleep(1); \
    if ((++_sp & 255u) == 0u) { if (xb_ld(&(bar)[XB_TMO])) break; if (_sp > XB_SPIN_CAP) { atomicAdd(&(bar)[XB_TMO], 1u); break; } } } } while (0)

struct XcdBarrier {
    unsigned* bar; unsigned x;
    volatile LAS unsigned* st;
};

__device__ __forceinline__ XcdBarrier xcd_barrier_post(unsigned* bar, volatile LAS unsigned* st) {
    XcdBarrier b; b.bar = bar; b.x = xb_xcc_id(); b.st = st;
    if (threadIdx.x == 0) (void)xb_add(&bar[XB_XCNT(b.x)], 1u);
    return b;
}
__device__ __forceinline__ void xcd_barrier_complete(unsigned* bar, unsigned x, unsigned& nloc, unsigned& nx) {
    const unsigned G = gridDim.x * gridDim.y * gridDim.z;
    unsigned sum, cnt, mine, sp = 0u;
    for (;;) {
        sum = 0u; cnt = 0u; mine = 0u;
#pragma unroll
        for (unsigned j = 0; j < 16; ++j) { const unsigned c = xb_ld(&bar[XB_XCNT(j)]); sum += c; cnt += (c > 0u) ? 1u : 0u; mine = (j == x) ? c : mine; }
        if (sum == G) break;
        __builtin_amdgcn_s_sleep(1);
        if ((++sp & 255u) == 0u) { if (xb_ld(&bar[XB_TMO])) break; if (sp > XB_SPIN_CAP) { atomicAdd(&bar[XB_TMO], 1u); break; } }
    }
    nloc = mine > 0u ? mine : 1u; nx = cnt > 0u ? cnt : 1u;
}

__device__ __forceinline__ void xcd_barrier(const XcdBarrier& b) {
    asm volatile("s_waitcnt vmcnt(0)" ::: "memory");
    __syncthreads();
    if (threadIdx.x == 0) {
        unsigned* bar = b.bar;
        __builtin_amdgcn_s_waitcnt(0);
        unsigned nloc = b.st[0], nx = b.st[1];
        if (nloc == 0u) { xcd_barrier_complete(bar, b.x, nloc, nx); b.st[0] = nloc; b.st[1] = nx; }
        const unsigned old = xb_add(&bar[XB_XSUB(b.x)], 1u);
        const unsigned gen = old / nloc;
        if (old + 1u == (gen + 1u) * nloc) {
            __builtin_amdgcn_fence(__ATOMIC_RELEASE, "agent");
            asm volatile("s_waitcnt vmcnt(0)" ::: "memory");
            const unsigned og = xb_add(&bar[XB_TOP], 1u);
            const unsigned tg = og / nx;
            if (og + 1u == (tg + 1u) * nx) xb_add(&bar[XB_TOPGEN], 1u);
            else XB_SPIN(xb_ld(&bar[XB_TOPGEN]) == tg, bar);
            __builtin_amdgcn_fence(__ATOMIC_ACQUIRE, "agent");
            xb_add(&bar[XB_XGEN(b.x)], 1u);
            asm volatile("s_waitcnt vmcnt(0)" ::: "memory");
        } else {
            XB_SPIN(xb_ld(&bar[XB_XGEN(b.x)]) == gen, bar);
            __builtin_amdgcn_fence(__ATOMIC_ACQUIRE, "agent");
            asm volatile("s_waitcnt vmcnt(0)" ::: "memory");
        }
    }
    __syncthreads();
}

struct TrItem { const float* W; bf16* WT; int ldw, ldt, k0, n0, drow0; float sc; };
__device__ __forceinline__ TrItem tr_decode(int r, const float* const* in, unsigned char* ws) {
    constexpr int I_A = 4 * 32 * 352, I_B = 4 * 88 * 64, I_C = 32 * 80, I_D = 32 * 64, I_E = 32 * 320;
    TrItem t; t.sc = 1.f;
    if (r < I_A) { const int mtx = r / (32 * 352), q = r % (32 * 352), kb = q / 352, nb = q % 352, n0 = 32 * nb, half = n0 >= FFD ? 1 : 0, np = n0 - half * FFD;
        t.W = in[7] + (size_t)mtx * 2048 * 11264; t.WT = (bf16*)(ws + WS_WFIN) + (size_t)mtx * 11264 * 2048; t.ldw = 11264; t.ldt = 2048; t.k0 = 64 * kb; t.n0 = n0; t.drow0 = (np >> 7) * 256 + half * 128 + (np & 127); t.sc = half ? 0.6931471805599453f : 1.4426950408889634f; return t; } r -= I_A;
    if (r < I_B) { const int mtx = r / (88 * 64), q = r % (88 * 64), kb = q / 64, nb = q % 64;
        t.W = in[8] + (size_t)mtx * FFD * 2048; t.WT = (bf16*)(ws + WS_WFOUT) + (size_t)mtx * 2048 * FFD; t.ldw = 2048; t.ldt = FFD; t.k0 = 64 * kb; t.n0 = 32 * nb; t.drow0 = 32 * nb; return t; } r -= I_B;
    if (r < I_C) { const int kb = r / 80, nb = r % 80; t.W = in[9]; t.WT = (bf16*)(ws + WS_WABIN); t.ldw = 3072; t.ldt = 2048; t.k0 = 64 * kb; t.n0 = 512 + 32 * nb; t.drow0 = 1024 + 32 * nb; return t; } r -= I_C;
    if (r < I_D) { const int kb = r / 64, nb = r % 64; t.W = in[11]; t.WT = (bf16*)(ws + WS_WABOUT); t.ldw = 2048; t.ldt = 2048; t.k0 = 64 * kb; t.n0 = 32 * nb; t.drow0 = 32 * nb; return t; } r -= I_D;
    if (r < I_E) { const int kb = r / 320, nb = r % 320; t.W = in[12]; t.WT = (bf16*)(ws + WS_WHGIN); t.ldw = 10240; t.ldt = 2048; t.k0 = 64 * kb; t.n0 = 32 * nb; t.drow0 = 32 * nb; return t; } r -= I_E;
    { const int kb = r / 64, nb = r % 64; t.W = in[15]; t.WT = (bf16*)(ws + WS_WHGOUT); t.ldw = 2048; t.ldt = 2048; t.k0 = 64 * kb; t.n0 = 32 * nb; t.drow0 = 32 * nb; return t; }
}
constexpr int TR_NITEMS = 4 * 32 * 352 + 4 * 88 * 64 + 32 * 80 + 32 * 64 + 32 * 320 + 32 * 64;
constexpr int TR_EARLY = TR_NITEMS;
__device__ __forceinline__ int tr_early_id(int e) { return e; }
__device__ __forceinline__ void tr_load(const TrItem& t, float (&v)[32], int lane) {
    const float* p = t.W + (size_t)(t.k0 + 32 * (lane >> 5)) * t.ldw + t.n0 + (lane & 31);
#pragma unroll
    for (int i = 0; i < 32; ++i) v[i] = p[(size_t)i * t.ldw];
}
__device__ __forceinline__ void tr_store(const TrItem& t, const float (&v)[32], LAS float* scr_f, int lane) {
    LAS unsigned* scr = (LAS unsigned*)scr_f;
    const int n = lane & 31, h = lane >> 5;
#pragma unroll
    for (int q = 0; q < 16; ++q) scr[n * 33 + 16 * h + q] = pk2(v[2 * q] * t.sc, v[2 * q + 1] * t.sc);
    LDS_WAIT(); asm volatile("" ::: "memory");
    const int c = lane & 7;
#pragma unroll
    for (int j = 0; j < 4; ++j) { const int nr = (lane >> 3) + 8 * j; const LAS unsigned* sp = scr + nr * 33 + 4 * c;
        v4u o; o.x = sp[0]; o.y = sp[1]; o.z = sp[2]; o.w = sp[3];
        *(GAS v4u*)(t.WT + (size_t)(t.drow0 + nr) * t.ldt + t.k0 + 8 * c) = o; }
    LDS_WAIT(); asm volatile("" ::: "memory");
}
struct Args { const float* in[17]; float* out; unsigned char* ws; int ph_lo, ph_hi; };

#ifndef PROBE_PRO
#define PROBE_PRO 31
#endif
__device__ __forceinline__ void prologue_phase(const Args& P, LAS unsigned char* lds, int vcu, int G, int rep) {
    int tid_o = threadIdx.x; asm volatile("" : "+v"(tid_o));
    const int tid = tid_o, lane = tid & 63, wave = __builtin_amdgcn_readfirstlane(tid >> 6);
    const int gw = vcu * NWAVES + wave, NGW = G * NWAVES;
    unsigned char* ws = P.ws;
    if (!rep || (PROBE_PRO & 1)) {
        LAS float* scr = (LAS float*)(lds + wave * 16384);
        float va[32], vb[32];
        int it = gw;
        if (it < TR_EARLY) { const TrItem t0 = tr_decode(tr_early_id(it), P.in, ws); tr_load(t0, va, lane); }
        for (; it < TR_EARLY; it += 2 * NGW) {
            const TrItem ta = tr_decode(tr_early_id(it), P.in, ws);
            const bool hb = it + NGW < TR_EARLY; TrItem tb = ta;
            if (hb) { tb = tr_decode(tr_early_id(it + NGW), P.in, ws); tr_load(tb, vb, lane); }
            tr_store(ta, va, scr, lane);
            if (it + 2 * NGW < TR_EARLY) { const TrItem tc = tr_decode(tr_early_id(it + 2 * NGW), P.in, ws); tr_load(tc, va, lane); }
            if (hb) tr_store(tb, vb, scr, lane);
        }
    }
    __syncthreads();
    if (!rep || (PROBE_PRO & 2)) {
        f32x2* rope = (f32x2*)(ws + WS_ROPE);
        for (int e = vcu * 512 + tid; e < 8192 * 64; e += G * 512) { const int t = e >> 6, i = e & 63, fi = i & 31, pos = (i >> 5) ? (t & 63) : (t >> 6);
            const float inv = powf(10000.f, -(float)(2 * fi) / 64.f), ang = (float)pos * inv; f32x2 cs; cs.x = cosf(ang); cs.y = sinf(ang); rope[e] = cs; }
    }
    if (!rep || (PROBE_PRO & 4)) {
        LAS bf16* tab = (LAS bf16*)lds;
        for (int j = tid; j < 8192; j += 512) tab[j] = (bf16)f2bf(cospif((float)j * (1.f / 4096.f)));
        __syncthreads();
        bf16* dfta = (bf16*)(ws + WS_DFTA);
        for (int k = vcu; k < 1024; k += G) if (tid < 256) { const int tp0 = tid * 8, part = tp0 >> 10, t0 = tp0 & 1023; unsigned v[8];
#pragma unroll
            for (int e = 0; e < 8; ++e) { const unsigned j = ((unsigned)k * (unsigned)(t0 + e)) & 1023u; const unsigned idx = part ? ((8u * j + 6144u) & 8191u) : 8u * j; v[e] = tab[idx]; }
            v4u o; o.x = v[0] | (v[1] << 16); o.y = v[2] | (v[3] << 16); o.z = v[4] | (v[5] << 16); o.w = v[6] | (v[7] << 16);
            *(GAS v4u*)(dfta + (size_t)k * 2048 + tp0) = o; }
        __syncthreads();
    }
    if (!rep || (PROBE_PRO & 8)) {
        LAS float* Wl = (LAS float*)lds;
        LAS float* tb = (LAS float*)(lds + 32768);
        if (tid < 128) tb[tid] = cospif((float)tid * (1.f / 64.f)) * 0.08838834764831845f;
        bf16* wt = (bf16*)(ws + WS_WABIN);
        for (int it = vcu; it < 256; it += G) { const int kb = it >> 2, g = it & 3;
            __syncthreads();
            for (int e = tid; e < 32 * 32; e += 512) { const int kk = e >> 5, c4 = e & 31; *(LAS f32x4*)(Wl + kk * 128 + 4 * c4) = *(const f32x4*)(P.in[9] + (size_t)(32 * kb + kk) * 3072 + g * 128 + 4 * c4); }
            __syncthreads();
            const int np = tid & 255, part = np >> 7, c2 = np & 127, kh = tid >> 8;
            float acc[16];
#pragma unroll
            for (int i = 0; i < 16; ++i) acc[i] = 0.f;
            for (int c = 0; c < 128; c += 4) { float t[4];
#pragma unroll
                for (int e = 0; e < 4; ++e) { int j = ((c + e) * c2) & 127; if (part) j = (j - 32) & 127; t[e] = tb[j]; }
#pragma unroll
                for (int i = 0; i < 16; ++i) { const f32x4 w4 = *(const LAS f32x4*)(Wl + (kh * 16 + i) * 128 + c); acc[i] += (w4.x * t[0] + w4.y * t[1]) + (w4.z * t[2] + w4.w * t[3]); } }
            bf16* dst = wt + (size_t)(part * 512 + g * 128 + c2) * 2048 + 32 * kb + kh * 16;
#pragma unroll
            for (int q = 0; q < 2; ++q) { v4u o; o.x = pk2(acc[8 * q], acc[8 * q + 1]); o.y = pk2(acc[8 * q + 2], acc[8 * q + 3]); o.z = pk2(acc[8 * q + 4], acc[8 * q + 5]); o.w = pk2(acc[8 * q + 6], acc[8 * q + 7]);
                *(GAS v4u*)(dst + 8 * q) = o; }
        }
        __syncthreads();
    }
    if (!rep || (PROBE_PRO & 16)) {
        LAS float* Sv = (LAS float*)lds;
        LAS float* red = (LAS float*)(lds + 32768);
        for (int e = tid; e < 3 * 2048; e += 512) { const int rr = e >> 11, k = e & 2047; const float v = rr < 2 ? P.in[1][rr * 2048 + k] : P.in[3][k]; Sv[e] = v / (1.f + expf(-v)); }
        __syncthreads();
        float* mod = (float*)(ws + WS_MOD);
        const int cl = tid & 15, kg = tid >> 4;
        for (int u = vcu; u < 576; u += G) { const int layer = u / 288, cb = u % 288;
            const float* wp = P.in[4] + (size_t)layer * 2048 * 18432 + (size_t)64 * cb + 4 * cl;
            f32x4 a0 = {0.f, 0.f, 0.f, 0.f}, a1 = a0, a2 = a0;
            for (int i0 = 0; i0 < 64; i0 += 8) { f32x4 w[8];
#pragma unroll
                for (int i = 0; i < 8; ++i) w[i] = *(const f32x4*)(wp + (size_t)(kg + 32 * (i0 + i)) * 18432);
#pragma unroll
                for (int i = 0; i < 8; ++i) { const int k = kg + 32 * (i0 + i); a0 += w[i] * Sv[k]; a1 += w[i] * Sv[2048 + k]; a2 += w[i] * Sv[4096 + k]; } }
            __syncthreads();
            LAS float* rp = red + (kg * 16 + cl) * 12;
            *(LAS f32x4*)(rp) = a0; *(LAS f32x4*)(rp + 4) = a1; *(LAS f32x4*)(rp + 8) = a2;
            __syncthreads();
            if (tid < 192) { const int c16 = tid / 12, q = tid % 12, rr = q >> 2, e = q & 3; float s = 0.f;
                for (int g2 = 0; g2 < 32; ++g2) s += red[(g2 * 16 + c16) * 12 + q];
                const int col = 64 * cb + 4 * c16 + e; mod[(size_t)(layer * 3 + rr) * 18432 + col] = s + P.in[5][layer * 18432 + col]; }
        }
        __syncthreads();
    }
}

__device__ __forceinline__ void norm_phase(bool from_input, int gw, int NGW, int lane_in, float* H, const float* x_in, const float* c_in, const float* gain, const float* modL, int js, int jc, bf16* XN,
                                           const float* SLAB, int nsl, const float* sgate, float scoef, bool s_from_input, bool skipctx, const bf16* DLT) {
    int lane = threadIdx.x; asm volatile("" : "+v"(lane)); lane &= 63; (void)lane_in;
    int cur = -1; f32x4 Av[8], Bv[8];
    for (int r = gw; r < MALL; r += NGW) {
        const int b = r / SB, s = r % SB, mrow = s < 256 ? 2 : b;
        if (skipctx && s < 256) continue;
        if (mrow != cur) { cur = mrow; const f32x4* sc = (const f32x4*)(modL + (size_t)mrow * 18432 + jc * 2048) + lane; const f32x4* sh = (const f32x4*)(modL + (size_t)mrow * 18432 + js * 2048) + lane; const f32x4* gp = (const f32x4*)gain + lane;
#pragma unroll
            for (int j = 0; j < 8; ++j) { Av[j] = gp[64 * j] * (sc[64 * j] + 1.f); Bv[j] = sh[64 * j]; } }
        const bool pend = nsl > 0 && s < 256;
        const float* xrow = (from_input || (pend && s_from_input)) ? (s < 256 ? c_in + ((size_t)b * 256 + s) * 2048 : x_in + ((size_t)b * 8192 + (s - 256)) * 2048) : H + (size_t)r * 2048;
        const GAS f32x4* xr = (const GAS f32x4*)xrow + lane;
        f32x4 v[8];
#pragma unroll
        for (int j = 0; j < 8; ++j) v[j] = xr[64 * j];
        if (DLT && s >= 256) {
            const GAS v2u* dq = (const GAS v2u*)(DLT + (size_t)r * 2048) + lane; GAS f32x4* hw = (GAS f32x4*)(H + (size_t)r * 2048) + lane;
#pragma unroll
            for (int j = 0; j < 8; ++j) { const v2u d = dq[64 * j]; v[j].x += bf2f(d.x & 0xffffu); v[j].y += bf2f(d.x >> 16); v[j].z += bf2f(d.y & 0xffffu); v[j].w += bf2f(d.y >> 16); hw[64 * j] = v[j]; }
        }
        if (pend) {
            f32x4 a[8];
#pragma unroll
            for (int j = 0; j < 8; ++j) a[j] = (f32x4){0.f, 0.f, 0.f, 0.f};
            for (int q = 0; q < nsl; ++q) { const GAS f32x4* sp = (const GAS f32x4*)(SLAB + ((size_t)q * 512 + b * 256 + s) * 2048) + lane;
#pragma unroll
                for (int j = 0; j < 8; ++j) a[j] += sp[64 * j]; }
            const f32x4* gq = (const f32x4*)sgate + lane; GAS f32x4* hw = (GAS f32x4*)(H + (size_t)r * 2048) + lane;
#pragma unroll
            for (int j = 0; j < 8; ++j) { v[j] += gq[64 * j] * scoef * a[j]; hw[64 * j] = v[j]; }
        }
        float ss = 0.f;
#pragma unroll
        for (int j = 0; j < 8; ++j) ss += (v[j].x * v[j].x + v[j].y * v[j].y) + (v[j].z * v[j].z + v[j].w * v[j].w);
        const float rstd = 1.f / sqrtf(wave_sum(ss) * (1.f / 2048.f) + EPS);
        GAS v2u* o8 = (GAS v2u*)(XN + (size_t)r * 2048) + lane;
#pragma unroll
        for (int j = 0; j < 8; ++j) { const f32x4 y = v[j] * rstd * Av[j] + Bv[j]; v2u w; w.x = pk2(y.x, y.y); w.y = pk2(y.z, y.w); o8[64 * j] = w; }
    }
}
__device__ __forceinline__ void final_phase(int gw, int NGW, int lane_in, const float* H, const float* fin, float* out, const bf16* DLT) {
    int lane = threadIdx.x; asm volatile("" : "+v"(lane)); lane &= 63; (void)lane_in;
    f32x4 g[8];
#pragma unroll
    for (int j = 0; j < 8; ++j) g[j] = ((const f32x4*)fin)[lane + 64 * j];
    for (int r = gw; r < NBATCH * SEQ; r += NGW) { const int b = r >> 13, t = r & 8191;
        const GAS f32x4* xr = (const GAS f32x4*)(H + ((size_t)b * SB + 256 + t) * 2048) + lane; const GAS v2u* dq = (const GAS v2u*)(DLT + ((size_t)b * SB + 256 + t) * 2048) + lane; f32x4 v[8]; float ss = 0.f;
#pragma unroll
        for (int j = 0; j < 8; ++j) { v[j] = xr[64 * j]; const v2u d = dq[64 * j]; v[j].x += bf2f(d.x & 0xffffu); v[j].y += bf2f(d.x >> 16); v[j].z += bf2f(d.y & 0xffffu); v[j].w += bf2f(d.y >> 16);
            ss += (v[j].x * v[j].x + v[j].y * v[j].y) + (v[j].z * v[j].z + v[j].w * v[j].w); }
        const float rstd = 1.f / sqrtf(wave_sum(ss) * (1.f / 2048.f) + EPS);
        GAS f32x4* o = (GAS f32x4*)(out + (size_t)r * 2048) + lane;
#pragma unroll
        for (int j = 0; j < 8; ++j) o[64 * j] = v[j] * rstd * g[j]; }
}
__device__ __forceinline__ void qknorm_rope_phase(int gw, int NGW, int lane_in, bf16* QB, bf16* KB, const float* qkn, const f32x2* rope) {
    int lane = threadIdx.x; asm volatile("" : "+v"(lane)); lane &= 63; (void)lane_in;
    const int j = lane & 15;
    for (int r = gw; r < MALL; r += NGW) { const int s = r % SB, b = r / SB;
#pragma unroll
        for (int hg = 3; hg < 4; ++hg) { const int Hh = 4 * hg + (lane >> 4);
            bf16* base = hg < 3 ? QB + (size_t)r * 1536 + Hh * 128 : KB + ((size_t)(b * 4 + (Hh - 12)) * SB + s) * 128; const float* gn = qkn + (hg < 3 ? 0 : 128);
            unsigned a[4]; float x[8];
#pragma unroll
            for (int q = 0; q < 4; ++q) { a[q] = *(const unsigned*)(base + 32 * q + 2 * j); x[2 * q] = bf2f(a[q] & 0xffffu); x[2 * q + 1] = bf2f(a[q] >> 16); }
            float ss = 0.f;
#pragma unroll
            for (int e = 0; e < 8; ++e) ss += x[e] * x[e];
            ss += __shfl_xor(ss, 1); ss += __shfl_xor(ss, 2); ss += __shfl_xor(ss, 4); ss += __shfl_xor(ss, 8);
            const float rs = 1.f / sqrtf(ss * (1.f / 128.f) + EPS);
#pragma unroll
            for (int q = 0; q < 4; ++q) { x[2 * q] *= rs * gn[32 * q + 2 * j]; x[2 * q + 1] *= rs * gn[32 * q + 2 * j + 1]; }
            if (s >= 256) { const f32x2* rp = rope + (size_t)(s - 256) * 64;
#pragma unroll
                for (int ax = 0; ax < 2; ++ax)
#pragma unroll
                    for (int e = 0; e < 2; ++e) { const f32x2 cs = rp[ax * 32 + 2 * j + e]; const float x1 = x[4 * ax + e], x2 = x[4 * ax + 2 + e];
                        x[4 * ax + e] = x1 * cs.x - x2 * cs.y; x[4 * ax + 2 + e] = x1 * cs.y + x2 * cs.x; } }
#pragma unroll
            for (int q = 0; q < 4; ++q) *(unsigned*)(base + 32 * q + 2 * j) = pk2(x[2 * q], x[2 * q + 1]);
        }
    }
}
__device__ __forceinline__ void readout_phase(int gw, int NGW, int lane_in, const bf16* OFW, const bf16* OBW, const bf16* HG, const float* onorm, bf16* XN) {
    int lane = threadIdx.x; asm volatile("" : "+v"(lane)); lane &= 63; (void)lane_in;
    float gn[8];
#pragma unroll
    for (int e = 0; e < 8; ++e) gn[e] = onorm[(8 * lane + e) & 127];
    for (int r = gw; r < MALL; r += NGW) { if (r % SB < 256) continue;
#pragma unroll
        for (int j = 0; j < 4; ++j) { const int col = 8 * lane + 512 * j;
            const size_t ho = ((size_t)(col >> 7) * MALL + r) * 128 + (col & 127);
            const v4u a = *(const GAS v4u*)(OFW + ho), bq = *(const GAS v4u*)(OBW + ho), gq = *(const GAS v4u*)(HG + (size_t)64 * MALL * 128 + ho);
            float o[8], sg[8];
#pragma unroll
            for (int q = 0; q < 4; ++q) { o[2 * q] = bf2f(a[q] & 0xffffu) + bf2f(bq[q] & 0xffffu); o[2 * q + 1] = bf2f(a[q] >> 16) + bf2f(bq[q] >> 16); sg[2 * q] = bf2f(gq[q] & 0xffffu); sg[2 * q + 1] = bf2f(gq[q] >> 16); }
            float ss = 0.f;
#pragma unroll
            for (int e = 0; e < 8; ++e) ss += o[e] * o[e];
            ss += __shfl_xor(ss, 1); ss += __shfl_xor(ss, 2); ss += __shfl_xor(ss, 4); ss += __shfl_xor(ss, 8);
            const float rs = 1.f / sqrtf(ss * (1.f / 128.f) + EPS);
            v4u w;
#pragma unroll
            for (int q = 0; q < 4; ++q) w[q] = pk2(o[2 * q] * rs * gn[2 * q] * sg[2 * q], o[2 * q + 1] * rs * gn[2 * q + 1] * sg[2 * q + 1]);
            *(GAS v4u*)(XN + (size_t)r * 2048 + col) = w; }
    }
}
__device__ __forceinline__ void ctx_dft_phase(LAS unsigned char* lds, int vcu, int G, const bf16* UWC, bf16* MIX) {
    LAS float* tb = (LAS float*)lds;
    int tid_o = threadIdx.x; asm volatile("" : "+v"(tid_o)); const int tid = tid_o;
    __syncthreads();
    if (tid < 256) tb[tid] = cospif((float)tid * (1.f / 128.f));
    __syncthreads();
    for (int e = vcu * 512 + tid; e < 256 * 1024; e += G * 512) { const int k1 = e >> 10, col = e & 1023, b = col >> 9, c = col & 511;
        const GAS v4u* up = (const GAS v4u*)(UWC + (size_t)col * 256); const GAS v4u* wp = (const GAS v4u*)(UWC + (size_t)(1024 + col) * 256);
        float accp = 0.f, accq = 0.f; unsigned j = 0;
        for (int t8 = 0; t8 < 32; ++t8) { const v4u uu = up[t8], ww = wp[t8];
#pragma unroll
            for (int q = 0; q < 4; ++q) {
                accp += bf2f(uu[q] & 0xffffu) * tb[j]; accq += bf2f(ww[q] & 0xffffu) * tb[(j + 192u) & 255u]; j = (j + (unsigned)k1) & 255u;
                accp += bf2f(uu[q] >> 16) * tb[j]; accq += bf2f(ww[q] >> 16) * tb[(j + 192u) & 255u]; j = (j + (unsigned)k1) & 255u; } }
        MIX[((size_t)b * SB + k1) * 2048 + c] = (bf16)f2bf((accp - accq) * 0.0625f); }
    __syncthreads();
}
__device__ __forceinline__ void fft8_prepass(LAS unsigned char* lds, int vcu, int G, const bf16* UWL, bf16* Y) {
    LAS float* ct = (LAS float*)lds;
    int tid_o = threadIdx.x; asm volatile("" : "+v"(tid_o)); const int tid = tid_o;
    __syncthreads();
    for (int j = tid; j < 8192; j += 512) ct[j] = cospif((float)j * (1.f / 4096.f));
    __syncthreads();
    for (int e = vcu * 512 + tid; e < 1024 * 128; e += G * 512) { const int col = e >> 7, o8 = (e & 127) * 8;
        const bf16* up = UWL + (size_t)col * 8192 + o8; const bf16* wp = UWL + (size_t)(1024 + col) * 8192 + o8;
        v4u uu[8], ww[8];
#pragma unroll
        for (int s = 0; s < 8; ++s) { uu[s] = *(const GAS v4u*)(up + 1024 * s); ww[s] = *(const GAS v4u*)(wp + 1024 * s); }
        v4u ore[8], oim[8];
#pragma unroll
        for (int qp = 0; qp < 4; ++qp) { float yr[2][8], yi[2][8];
#pragma unroll
            for (int hq = 0; hq < 2; ++hq) { float zr[8], zi[8];
#pragma unroll
                for (int s = 0; s < 8; ++s) { zr[s] = bf2f(hq ? (uu[s][qp] >> 16) : (uu[s][qp] & 0xffffu)); zi[s] = -bf2f(hq ? (ww[s][qp] >> 16) : (ww[s][qp] & 0xffffu)); }
                float er[4], ei[4], dr[4], di[4];
                { const float ar = zr[0] + zr[4], ai = zi[0] + zi[4], br = zr[0] - zr[4], bi = zi[0] - zi[4], cr = zr[2] + zr[6], ci = zi[2] + zi[6], fr_ = zr[2] - zr[6], fi = zi[2] - zi[6];
                  er[0] = ar + cr; ei[0] = ai + ci; er[2] = ar - cr; ei[2] = ai - ci; er[1] = br + fi; ei[1] = bi - fr_; er[3] = br - fi; ei[3] = bi + fr_; }
                { const float ar = zr[1] + zr[5], ai = zi[1] + zi[5], br = zr[1] - zr[5], bi = zi[1] - zi[5], cr = zr[3] + zr[7], ci = zi[3] + zi[7], fr_ = zr[3] - zr[7], fi = zi[3] - zi[7];
                  dr[0] = ar + cr; di[0] = ai + ci; dr[2] = ar - cr; di[2] = ai - ci; dr[1] = br + fi; di[1] = bi - fr_; dr[3] = br - fi; di[3] = bi + fr_; }
                const float R2 = 0.70710678118654752f;
                float tr[4], ti[4];
                tr[0] = dr[0]; ti[0] = di[0];
                tr[1] = (dr[1] + di[1]) * R2; ti[1] = (di[1] - dr[1]) * R2;
                tr[2] = di[2]; ti[2] = -dr[2];
                tr[3] = (di[3] - dr[3]) * R2; ti[3] = (-di[3] - dr[3]) * R2;
                const unsigned tpp = (unsigned)(o8 + 2 * qp + hq);
#pragma unroll
                for (int m = 0; m < 4; ++m) {
#pragma unroll
                    for (int hh = 0; hh < 2; ++hh) { const int kap = m + 4 * hh; const float ar = hh ? er[m] - tr[m] : er[m] + tr[m], ai = hh ? ei[m] - ti[m] : ei[m] + ti[m];
                        const unsigned j = (unsigned)kap * tpp; const float c = ct[j], sn = ct[(j + 6144u) & 8191u];
                        yr[hq][kap] = ar * c + ai * sn; yi[hq][kap] = ai * c - ar * sn; } }
            }
#pragma unroll
            for (int kap = 0; kap < 8; ++kap) { ore[kap][qp] = pg8::cvt_pk_bf16(yr[0][kap], yr[1][kap]); oim[kap][qp] = pg8::cvt_pk_bf16(yi[0][kap], yi[1][kap]); }
        }
#pragma unroll
        for (int kap = 0; kap < 8; ++kap) { bf16* yp = Y + ((size_t)(kap * 1024 + col)) * 2048 + o8; *(GAS v4u*)yp = ore[kap]; *(GAS v4u*)(yp + 1024) = oim[kap]; }
    }
    __syncthreads();
}


__device__ __forceinline__ int crow(int r, int hi) { return (r & 3) + 8 * (r >> 2) + 4 * hi; }
__device__ __forceinline__ bf16x8 pack8(const f32x16& x, int s8) {
    v4u w; w.x = pg8::cvt_pk_bf16(x[s8 + 0], x[s8 + 1]); w.y = pg8::cvt_pk_bf16(x[s8 + 2], x[s8 + 3]); w.z = pg8::cvt_pk_bf16(x[s8 + 4], x[s8 + 5]); w.w = pg8::cvt_pk_bf16(x[s8 + 6], x[s8 + 7]);
    return __builtin_bit_cast(bf16x8, w);
}
__device__ __forceinline__ bf16x8 ld_b128(const LAS unsigned char* p) { return *(const LAS bf16x8*)p; }
__device__ __forceinline__ bf16x8 ld_2xb64(const LAS unsigned char* p0, const LAS unsigned char* p1) { const v2u a = *(const LAS v2u*)p0, b = *(const LAS v2u*)p1; v4u w; w.x = a.x; w.y = a.y; w.z = b.x; w.w = b.y; return __builtin_bit_cast(bf16x8, w); }
__device__ __forceinline__ unsigned off_b(unsigned row, unsigned ch) { return 256u * row + 16u * (ch ^ (((row & 3u) << 2) | ((row >> 2) & 3u))); }
typedef short v4i16_t __attribute__((ext_vector_type(4)));
__device__ __forceinline__ s16x4 vtr(const LAS unsigned char* p) { return __builtin_bit_cast(s16x4, __builtin_amdgcn_ds_read_tr16_b64_v4i16((LAS v4i16_t*)p)); }
__device__ __forceinline__ bf16x8 tr_pair(const LAS unsigned char* img, unsigned rowA, unsigned rowB, unsigned cblk, unsigned lane) {
    const unsigned blk = (lane >> 4) & 1u, q = (lane & 15u) >> 2, p = lane & 3u, ch = 4u * cblk + 2u * blk + (p >> 1), sub = 8u * (p & 1u);
    const s16x4 lo = vtr(img + off_b(rowA + q, ch) + sub), hi4 = vtr(img + off_b(rowB + q, ch) + sub);
    return (bf16x8){lo[0], lo[1], lo[2], lo[3], hi4[0], hi4[1], hi4[2], hi4[3]};
}
constexpr int SC_Q1 = 0, SC_K1 = 16384, SC_V = 32768, SC_TOT = 49152, SC_EBL = 57344, SC_HALF = 57856;
template <bool FULL>
__device__ __forceinline__ void hgrn_scan(LAS unsigned char* lds, int vcu, int G, const bf16* HG, float* USEG, float* DSEG, bf16* OFW, bf16* OBW, int probe = 0) {
    int tid_o = threadIdx.x; asm volatile("" : "+v"(tid_o));
    const int tid = tid_o, half = __builtin_amdgcn_readfirstlane(tid >> 8), ht = tid & 255, w = __builtin_amdgcn_readfirstlane((tid >> 6) & 3), lane = tid & 63, l31 = lane & 31, hi = lane >> 5;
    LAS unsigned char* base = lds + half * SC_HALF;
    LAS unsigned char* Q1 = base + SC_Q1;
    LAS unsigned char* K1 = base + SC_K1;
    LAS unsigned char* Vi = base + SC_V;
    LAS float* TOT = (LAS float*)(base + SC_TOT);
    LAS float* EBL = (LAS float*)(base + SC_EBL);
    const int cg = ht & 15, rg = ht >> 4, dir = half;
    bf16* OD = dir ? OBW : OFW;
    for (int wi = vcu; wi < (FULL ? 1024 : 1056); wi += G) {
        const int b = FULL ? wi >> 9 : wi / 528, rem = FULL ? wi & 511 : wi % 528, h = FULL ? rem >> 5 : rem / 33, p = FULL ? (rem & 31) + 1 : rem % 33;
        const int it = ((b * 16 + h) * 2 + dir) * 33 + p;
        const size_t row0 = (size_t)b * SB + (size_t)p * 256;
        f32x16 S[4];
        if (FULL) {
#pragma unroll
            for (int kb = 0; kb < 4; ++kb)
#pragma unroll
                for (int r8 = 0; r8 < 2; ++r8) { const v4u t = *(const GAS v4u*)((const bf16*)USEG + (size_t)it * 16384 + (size_t)((w * 4 + kb) * 64 + lane) * 16 + 8 * r8);
#pragma unroll
                    for (int q = 0; q < 4; ++q) { S[kb][8 * r8 + 2 * q] = bf2f(t[q] & 0xffffu); S[kb][8 * r8 + 2 * q + 1] = bf2f(t[q] >> 16); } }
        } else {
#pragma unroll
            for (int kb = 0; kb < 4; ++kb)
#pragma unroll
                for (int r = 0; r < 16; ++r) S[kb][r] = 0.f;
        }
        float dtot[8];
#pragma unroll
        for (int e = 0; e < 8; ++e) dtot[e] = 1.f;
        v4u lfq[4], qq[4], vq[4];
#define SC_LOAD(jj) do { _Pragma("unroll") for (int i = 0; i < 4; ++i) { const int tl = 64 * (jj) + 4 * rg + i; const bf16* rp = HG + ((size_t)((1 + dir) * 16 + h) * MALL + row0 + (dir ? 255 - tl : tl)) * 128 + 8 * cg; \
                    lfq[i] = *(const GAS v4u*)rp; } } while (0)
        SC_LOAD(0);
        for (int j = 0; j < 4; ++j) {
            v4u lfk[4];
            {
#pragma unroll
                for (int i = 0; i < 4; ++i) { lfk[i] = lfq[i]; const int tl = 64 * j + 4 * rg + i; const size_t ro = ((size_t)h * MALL + row0 + (dir ? 255 - tl : tl)) * 128 + 8 * cg; vq[i] = *(const GAS v4u*)(HG + (size_t)48 * MALL * 128 + ro); if (FULL) qq[i] = *(const GAS v4u*)(HG + ro); }
                float run[8];
#pragma unroll
                for (int e = 0; e < 8; ++e) run[e] = 1.f;
#pragma unroll
                for (int i = 0; i < 4; ++i)
#pragma unroll
                    for (int e = 0; e < 8; ++e) { const unsigned u = (e & 1) ? (lfk[i][e >> 1] >> 16) : (lfk[i][e >> 1] & 0xffffu); run[e] *= (float)u * (1.f / 65535.f); }
                *(LAS f32x4*)(TOT + rg * 128 + 8 * cg) = (f32x4){run[0], run[1], run[2], run[3]}; *(LAS f32x4*)(TOT + rg * 128 + 8 * cg + 4) = (f32x4){run[4], run[5], run[6], run[7]};
            }
            __syncthreads();
            {
                if (ht < 128 && !(probe & 8)) { float t[16];
#pragma unroll
                    for (int g2 = 0; g2 < 16; ++g2) t[g2] = TOT[g2 * 128 + ht];
                    float ex = 1.f;
#pragma unroll
                    for (int g2 = 0; g2 < 16; ++g2) { TOT[g2 * 128 + ht] = ex; ex *= t[g2]; }
                    EBL[ht] = ex; }
                __syncthreads();
                float off[8], bl[8];
                { const f32x4 p0 = *(const LAS f32x4*)(TOT + rg * 128 + 8 * cg), p1 = *(const LAS f32x4*)(TOT + rg * 128 + 8 * cg + 4), b0 = *(const LAS f32x4*)(EBL + 8 * cg), b1 = *(const LAS f32x4*)(EBL + 8 * cg + 4);
#pragma unroll
                  for (int e = 0; e < 4; ++e) { off[e] = p0[e]; off[4 + e] = p1[e]; bl[e] = b0[e]; bl[4 + e] = b1[e]; } }
#pragma unroll
                for (int e = 0; e < 8; ++e) dtot[e] *= bl[e];
                if (!(probe & 4))
#pragma unroll
                for (int i = 0; i < 4; ++i) { float k1[8], q1[8];
#pragma unroll
                    for (int e = 0; e < 8; ++e) { const unsigned u = (e & 1) ? (lfk[i][e >> 1] >> 16) : (lfk[i][e >> 1] & 0xffffu); const float fd = (float)u * (1.f / 65535.f); off[e] = fmaxf(off[e] * fd, 1e-30f);
                        k1[e] = (1.f - fd) * __builtin_amdgcn_rcpf(off[e]);
                        if (FULL) { const unsigned qu = (e & 1) ? (qq[i][e >> 1] >> 16) : (qq[i][e >> 1] & 0xffffu); q1[e] = bf2f(qu) * off[e]; } }
                    v4u o; o.x = pg8::cvt_pk_bf16(k1[0], k1[1]); o.y = pg8::cvt_pk_bf16(k1[2], k1[3]); o.z = pg8::cvt_pk_bf16(k1[4], k1[5]); o.w = pg8::cvt_pk_bf16(k1[6], k1[7]);
                    *(LAS v4u*)(K1 + off_b(4 * rg + i, cg)) = o; *(LAS v4u*)(Vi + off_b(4 * rg + i, cg)) = vq[i];
                    if (FULL) { v4u o2; o2.x = pg8::cvt_pk_bf16(q1[0], q1[1]); o2.y = pg8::cvt_pk_bf16(q1[2], q1[3]); o2.z = pg8::cvt_pk_bf16(q1[4], q1[5]); o2.w = pg8::cvt_pk_bf16(q1[6], q1[7]);
                        *(LAS v4u*)(Q1 + off_b(4 * rg + i, cg)) = o2; }
                    asm volatile("" ::: "memory"); }
                if (j < 3) SC_LOAD(j + 1);
            }
            __syncthreads();
            f32x16 o0, o1;
            if (FULL && !(probe & 1)) {
#pragma unroll
                for (int r = 0; r < 16; ++r) { o0[r] = 0.f; o1[r] = 0.f; }
#pragma unroll
                for (int blk = 0; blk < 3; ++blk) { const int sb_ = blk == 2 ? 1 : 0, tb_ = blk == 0 ? 0 : 1;
                    f32x16 X;
#pragma unroll
                    for (int r = 0; r < 16; ++r) X[r] = 0.f;
#pragma unroll 4
                    for (int ks = 0; ks < 8; ++ks) X = __builtin_amdgcn_mfma_f32_32x32x16_bf16(ld_b128(K1 + off_b(32 * sb_ + l31, 2 * ks + hi)), ld_b128(Q1 + off_b(32 * tb_ + l31, 2 * ks + hi)), X, 0, 0, 0);
                    if (sb_ == tb_) {
#pragma unroll
                        for (int r = 0; r < 16; ++r) X[r] = crow(r, hi) <= l31 ? X[r] : 0.f; }
#pragma unroll
                    for (int sp = 0; sp < 2; ++sp) { const bf16x8 vb = tr_pair(Vi, 32 * sb_ + 16 * sp + 4 * hi, 32 * sb_ + 16 * sp + 4 * hi + 8, w, lane);
                        if (tb_ == 0) o0 = __builtin_amdgcn_mfma_f32_32x32x16_bf16(pack8(X, 8 * sp), vb, o0, 0, 0, 0); else o1 = __builtin_amdgcn_mfma_f32_32x32x16_bf16(pack8(X, 8 * sp), vb, o1, 0, 0, 0); }
                    asm volatile("" ::: "memory"); }
#pragma unroll
                for (int kb = 0; kb < 4; ++kb)
#pragma unroll
                    for (int sp = 0; sp < 2; ++sp) { asm volatile("" ::: "memory"); const bf16x8 sb = pack8(S[kb], 8 * sp); const unsigned ch = 4 * kb + 2 * sp, sub = 8 * hi;
                        const bf16x8 qa0 = ld_2xb64(Q1 + off_b(l31, ch) + sub, Q1 + off_b(l31, ch + 1) + sub), qa1 = ld_2xb64(Q1 + off_b(32 + l31, ch) + sub, Q1 + off_b(32 + l31, ch + 1) + sub);
                        o0 = __builtin_amdgcn_mfma_f32_32x32x16_bf16(qa0, sb, o0, 0, 0, 0);
                        o1 = __builtin_amdgcn_mfma_f32_32x32x16_bf16(qa1, sb, o1, 0, 0, 0); }
            }
            if ((!FULL || j < 3) && !(probe & 1)) {
#pragma unroll
                for (int st = 0; st < 4; ++st) { const bf16x8 vb = tr_pair(Vi, 16 * st + 8 * hi, 16 * st + 8 * hi + 4, w, lane);
#pragma unroll
                    for (int kb = 0; kb < 4; ++kb) S[kb] = __builtin_amdgcn_mfma_f32_32x32x16_bf16(tr_pair(K1, 16 * st + 8 * hi, 16 * st + 8 * hi + 4, kb, lane), vb, S[kb], 0, 0, 0); }
#pragma unroll
                for (int kb = 0; kb < 4; ++kb)
#pragma unroll
                    for (int r4 = 0; r4 < 4; ++r4) { const f32x4 eb = *(const LAS f32x4*)(EBL + 32 * kb + 8 * r4 + 4 * hi);
#pragma unroll
                        for (int e = 0; e < 4; ++e) S[kb][4 * r4 + e] *= eb[e]; }
            }
            __syncthreads();
            if (FULL && !(probe & 2)) {
#pragma unroll
                for (int r = 0; r < 16; ++r) { const int t0 = crow(r, hi);
                    *(LAS bf16*)(Q1 + t0 * 256 + (32 * w + l31) * 2) = (bf16)pg8::cvt_pk_bf16(o0[r], 0.f); *(LAS bf16*)(Q1 + (32 + t0) * 256 + (32 * w + l31) * 2) = (bf16)pg8::cvt_pk_bf16(o1[r], 0.f); }
                __syncthreads();
#pragma unroll
                for (int i = 0; i < 4; ++i) { const int tl = 64 * j + 4 * rg + i; *(GAS v4u*)(OD + ((size_t)h * MALL + row0 + (dir ? 255 - tl : tl)) * 128 + 8 * cg) = *(const LAS v4u*)(Q1 + (4 * rg + i) * 256 + 16 * cg); }
            }
        }
        if (!FULL && !(probe & 2)) {
#pragma unroll
            for (int kb = 0; kb < 4; ++kb)
#pragma unroll
                for (int r8 = 0; r8 < 2; ++r8) { v4u t;
#pragma unroll
                    for (int q = 0; q < 4; ++q) t[q] = pg8::cvt_pk_bf16(S[kb][8 * r8 + 2 * q], S[kb][8 * r8 + 2 * q + 1]);
                    *(GAS v4u*)((bf16*)USEG + (size_t)it * 16384 + (size_t)((w * 4 + kb) * 64 + lane) * 16 + 8 * r8) = t; }
            if (rg == 0) { float* dp = DSEG + it * 128 + 8 * cg; *(f32x4*)dp = (f32x4){dtot[0], dtot[1], dtot[2], dtot[3]}; *(f32x4*)(dp + 4) = (f32x4){dtot[4], dtot[5], dtot[6], dtot[7]}; }
        }
    }
}
#undef SC_LOAD
__device__ __forceinline__ void hgrn_combine(int vcu, int G, float* USEG_f, const float* DSEG) {
    int tid_o = threadIdx.x; asm volatile("" : "+v"(tid_o));
    bf16* USEG = (bf16*)USEG_f;
    const int gt = vcu * 512 + tid_o, NT = G * 512;
    for (int e8 = gt; e8 < 64 * 2048; e8 += NT) { const int chain = e8 >> 11, idx8 = e8 & 2047, dir = chain & 1;
        const int k0 = 32 * ((idx8 >> 7) & 3) + 16 * (idx8 & 1) + 4 * ((idx8 >> 6) & 1);
        float carry[8];
#pragma unroll
        for (int e = 0; e < 8; ++e) carry[e] = 0.f;
        for (int i0 = 0; i0 < 33; i0 += 11) { v4u t[11]; f32x4 d0[11], d1[11];
#pragma unroll
            for (int i = 0; i < 11; ++i) { const int ii = i0 + i, p = (dir == 0 || ii == 0) ? ii : 33 - ii; t[i] = *(const GAS v4u*)(USEG + ((size_t)(chain * 33 + p) * 2048 + idx8) * 8);
                d0[i] = *(const f32x4*)(DSEG + (chain * 33 + p) * 128 + k0); d1[i] = *(const f32x4*)(DSEG + (chain * 33 + p) * 128 + k0 + 8); }
#pragma unroll
            for (int i = 0; i < 11; ++i) { const int ii = i0 + i, p = (dir == 0 || ii == 0) ? ii : 33 - ii; v4u o;
#pragma unroll
                for (int q = 0; q < 4; ++q) o[q] = pg8::cvt_pk_bf16(carry[2 * q], carry[2 * q + 1]);
                *(GAS v4u*)(USEG + ((size_t)(chain * 33 + p) * 2048 + idx8) * 8) = o;
#pragma unroll
                for (int q = 0; q < 4; ++q) { const float dl = q < 2 ? d0[i][2 * q] : d1[i][2 * q - 4], dh = q < 2 ? d0[i][2 * q + 1] : d1[i][2 * q - 3];
                    carry[2 * q] = carry[2 * q] * dl + bf2f(t[i][q] & 0xffffu); carry[2 * q + 1] = carry[2 * q + 1] * dh + bf2f(t[i][q] >> 16); } }
        }
    }
}
__global__ void __launch_bounds__(NWAVES * 64, 2) mk_fwd(Args args) {
    extern __shared__ __attribute__((aligned(16))) unsigned char lds_raw[];
    LAS unsigned char* lds = (LAS unsigned char*)lds_raw;
    const int tid = threadIdx.x, lane = 0, wave = __builtin_amdgcn_readfirstlane(tid >> 6);
    const int G = gridDim.x, bx = blockIdx.x, vcu = (G % 8 == 0) ? (bx % 8) * (G / 8) + bx / 8 : bx;
    const int gw = vcu * NWAVES + wave, NGW = G * NWAVES;
    unsigned char* ws = args.ws;
    volatile LAS unsigned* MISC = (volatile LAS unsigned*)(lds + MISC_OFF);
    for (int u = tid; u < (LDS_BYTES - MISC_OFF) / 4; u += NWAVES * 64) ((LAS unsigned*)(lds + MISC_OFF))[u] = 0u;
    __syncthreads();
    unsigned* ctl = (unsigned*)(ws + WS_CTL);
    XcdBarrier bar; bar.bar = ctl + CW_BAR; bar.x = 0; bar.st = nullptr;
    if (!MK_SPLIT) bar = xcd_barrier_post(ctl + CW_BAR, MISC + 8);
#define GRID_BAR() do { if (!MK_SPLIT) xcd_barrier(bar); } while (0)
    const int lo = args.ph_lo, hi = args.ph_hi; (void)lo; (void)hi;
#ifndef ONLY_SITE
#define ONLY_SITE -1
#endif
#if MK_SPLIT
#define INS(site, k) ((ONLY_SITE < 0 || ONLY_SITE == (site)) && lo <= (k) && (k) < hi)
#else
#define INS(site, k) (ONLY_SITE < 0 || ONLY_SITE == (site))
#endif
#ifndef DUP_MASK
#define DUP_MASK 0
#endif
#ifndef DUP_N
#define DUP_N 1
#endif
#ifndef RES_ALIGN
#define RES_ALIGN true
#endif
#ifndef FFN_ALIGN
#define FFN_ALIGN true
#endif
#ifndef FFN_SP2
#define FFN_SP2 true
#endif
#ifndef PROBE_SCAN
#define PROBE_SCAN 0
#endif
#define REPS(site) for (int rep = 0; rep < 1 + (((DUP_MASK >> (site)) & 1) ? DUP_N : 0); ++rep)
#define H_ ((float*)(ws + WS_H))
#define XN_ ((bf16*)(ws + WS_XN))
#define HID_ ((bf16*)(ws + WS_HID))
#define MOD_ ((float*)(ws + WS_MOD))
#define MIX_ ((bf16*)(ws + WS_MIX))
#define QB_ ((bf16*)(ws + WS_QB))
#define KB_ ((bf16*)(ws + WS_KB))
#define VB_ ((bf16*)(ws + WS_VB))
#define HG_ ((bf16*)(ws + WS_HG))
#define OFW_ ((bf16*)(ws + WS_OFW))
#define OBW_ ((bf16*)(ws + WS_OBW))
#define USEG_ ((float*)(ws + WS_USEG))
#define DSEG_ ((float*)(ws + WS_DSEG))
#define SLAB_ ((float*)(ws + WS_SLAB))
#define DLT_ ((bf16*)(ws + WS_DLT))
    if (INS(0, 0)) REPS(0) { prologue_phase(args, lds, vcu, G, rep); GRID_BAR(); }

    {
        constexpr int f = 0;
        const int layer = f >> 1, sub = f & 1;
        const float* modL = MOD_ + (size_t)layer * 3 * 18432;
        const float* gainL = args.in[6] + (size_t)layer * 3 * 2048;
        if (sub == 1) {
            const int mb = layer == 0 ? 4 : 15;
            if (INS(1, mb)) REPS(1) { norm_phase(layer == 0 && !rep, gw, NGW, lane, H_, args.in[0], args.in[2], gainL + 2048, modL, 3, 4, XN_, SLAB_, rep ? 0 : 11, modL + 2 * 18432 + 2 * 2048, 0.5f, layer == 0, false, rep ? nullptr : DLT_); GRID_BAR(); }
            if (layer == 0) {
                if (INS(2, 5)) REPS(2) {
                    const bf16* wqkv = (const bf16*)(ws + WS_WABIN) + (size_t)1024 * 2048; const bf16* wf = (const bf16*)(ws + WS_WABIN);
                    pg8::Gemm g{XN_, wqkv, 2048, 2048, (size_t)((const char*)wf - (const char*)XN_), (size_t)((const char*)XN_ - (const char*)wqkv)};
                    pg8::ABOrder S; S.so.init(MALL, 2560, 2048, G, bx); S.G = G; S.c = bx;
                    pg8::EpiAB E{(bf16*)(ws + WS_UWL), (bf16*)(ws + WS_UWC), QB_, KB_, VB_};
                    pg8::gemm_phase<pg8::EpiAB, pg8::ABOrder, true, true>(lds, g, S, E);
                    GRID_BAR(); }
                if (INS(3, 6)) REPS(3) { qknorm_rope_phase(gw, NGW, lane, QB_, KB_, args.in[10], (const f32x2*)(ws + WS_ROPE)); fft8_prepass(lds, vcu, G, (const bf16*)(ws + WS_UWL), (bf16*)(ws + WS_DFT)); GRID_BAR(); }
                if (INS(4, 7) || (ONLY_SITE == 15 || ONLY_SITE == 16)) REPS(4) {
#ifndef PROBE_ATT
#define PROBE_ATT 3
#endif
                    if (ONLY_SITE != 15 && (!rep || (PROBE_ATT & 1))) for (int i = 0;; ++i) { const int L = i * G + vcu; if (L >= 792) break;
                        int b, hq, seq; size_t qrow; const float* ropeb;
                        if (L < 768) { b = L / 384; const int rem = L % 384; hq = rem >> 5; qrow = (size_t)b * SB + 256 + (size_t)(rem & 31) * 256; seq = SB; ropeb = (const float*)(ws + WS_ROPE) + (size_t)(rem & 31) * 256 * 128; }
                        else { const int jx = L - 768; b = jx / 12; hq = jx % 12; qrow = (size_t)b * SB; seq = 256; ropeb = nullptr; }
                        const size_t kvoff = (size_t)(b * 4 + hq / 3) * SB * 128;
                        attn::attn_dense_body<attn::bf16>((const attn::bf16*)(QB_ + qrow * 1536 + hq * 128), (const attn::bf16*)(KB_ + kvoff), (const attn::bf16*)(VB_ + kvoff), MIX_ + qrow * 2048 + 512 + hq * 128, seq, (char*)lds_raw, args.in[10], ropeb);
                        __syncthreads(); }
                    __syncthreads();
                    if (ONLY_SITE != 16 && (!rep || (PROBE_ATT & 2))) { pg8::Gemm g{(const bf16*)(ws + WS_DFTA), (const bf16*)(ws + WS_DFT), 2048, 2048, 0, 0};
                      pg8::DftOrder S{4, 32, 1, G, bx, 2048 / 64}; pg8::EpiDFT E{MIX_, 0.011048543456039806f};
                      pg8::gemm_phase<pg8::EpiDFT, pg8::DftOrder, true, true>(lds, g, S, E); }
                    if (ONLY_SITE != 16) { if (G == 256) { if (bx >= 128) ctx_dft_phase(lds, bx - 128, 128, (const bf16*)(ws + WS_UWC), MIX_); }
                                           else ctx_dft_phase(lds, vcu, G, (const bf16*)(ws + WS_UWC), MIX_); }
                    GRID_BAR(); }
            } else {
                if (INS(5, 16)) REPS(5) {
                    pg8::Gemm g{XN_, (const bf16*)(ws + WS_WHGIN), 2048, 2048, 0, 0}; pg8::StaticOrder S; S.init(MALL, 10240, 2048, G, bx);
                    pg8::EpiHG E{HG_, args.in[13]};
                    pg8::gemm_phase<pg8::EpiHG, pg8::StaticOrder, true, true>(lds, g, S, E);
                    GRID_BAR(); }
                if (INS(6, 17)) REPS(6) { hgrn_scan<false>(lds, vcu, G, HG_, USEG_, DSEG_, OFW_, OBW_, rep ? PROBE_SCAN : 0); GRID_BAR(); }
                if (INS(7, 18)) REPS(7) { hgrn_combine(vcu, G, USEG_, DSEG_); GRID_BAR(); }
                if (INS(8, 19)) REPS(8) { hgrn_scan<true>(lds, vcu, G, HG_, USEG_, DSEG_, OFW_, OBW_, rep ? PROBE_SCAN : 0); GRID_BAR(); }
                if (INS(9, 20)) REPS(9) { readout_phase(gw, NGW, lane, OFW_, OBW_, HG_, args.in[14], XN_); GRID_BAR(); }
            }
            if (INS(10, mb + (layer == 0 ? 4 : 6))) REPS(10) {
                pg8::Gemm g; int Kk; if (layer == 0) { g = pg8::Gemm{MIX_, (const bf16*)(ws + WS_WABOUT), 2048, 2048, 0, 0}; Kk = 2048; } else { g = pg8::Gemm{XN_, (const bf16*)(ws + WS_WHGOUT), 2048, 2048, 0, 0}; Kk = 2048; }
                pg8::ResidOrder S; S.so.init(MALL, 2048, Kk, G, bx, 1); S.nsl = layer == 0 ? 4 : 0;
                pg8::EpiResid E{rep ? XN_ : DLT_, modL + 5 * 2048, 1.f, SLAB_, rep};
                pg8::gemm_phase<pg8::EpiResid, pg8::ResidOrder, RES_ALIGN, true>(lds, g, S, E);
                GRID_BAR(); }
        }
        const int pb = f == 0 ? 1 : f == 1 ? 9 : f == 2 ? 12 : 22;
        const int jb = sub == 0 ? 0 : 6;
        if (INS(11, pb)) REPS(11) {
            const float* sg = f == 1 ? modL + 2 * 18432 + 5 * 2048 : MOD_ + 2 * 18432 + 8 * 2048;
            norm_phase(f == 0, gw, NGW, lane, H_, args.in[0], args.in[2], gainL + (sub == 0 ? 0 : 2) * 2048, modL, jb, jb + 1, XN_, SLAB_, rep ? 0 : f == 1 ? 4 : f == 2 ? 11 : 0, sg, f == 1 ? 1.f : 0.5f, false, f == 3, (f == 0 || rep) ? nullptr : DLT_); GRID_BAR(); }
        if (INS(12, pb + 1)) REPS(12) {
            pg8::Gemm g{XN_, (const bf16*)(ws + WS_WFIN) + (size_t)f * 11264 * 2048, 2048, 2048, 0, 0}; pg8::StaticOrder S; S.init(MALL, 11264, 2048, G, bx, f == 3);
            pg8::EpiSwiGLU E{HID_, FFD};
            pg8::gemm_phase<pg8::EpiSwiGLU, pg8::StaticOrder, FFN_ALIGN, FFN_SP2>(lds, g, S, E);
            GRID_BAR(); }
        if (INS(13, pb + 2)) REPS(13) {
            pg8::Gemm g{HID_, (const bf16*)(ws + WS_WFOUT) + (size_t)f * 2048 * FFD, 64, FFD, 0, 0, (size_t)256 * 64 * 2, (size_t)(FFD / 64) * 256 * 64 * 2};
#ifdef PROBE_SAMEA
            if (rep) g.tstA = 64;
#endif
            pg8::ResidOrder S; S.so.init(MALL, 2048, FFD, G, bx, 1); S.nsl = f == 3 ? 0 : 11;
            pg8::EpiResid E{rep ? XN_ : DLT_, modL + (jb + 2) * 2048, 0.5f, SLAB_, rep};
            pg8::gemm_phase<pg8::EpiResid, pg8::ResidOrder, RES_ALIGN, true>(lds, g, S, E);
            GRID_BAR(); }
        }
    {
        constexpr int f = 1;
        const int layer = f >> 1, sub = f & 1;
        const float* modL = MOD_ + (size_t)layer * 3 * 18432;
        const float* gainL = args.in[6] + (size_t)layer * 3 * 2048;
        if (sub == 1) {
            const int mb = layer == 0 ? 4 : 15;
            if (INS(1, mb)) REPS(1) { norm_phase(layer == 0 && !rep, gw, NGW, lane, H_, args.in[0], args.in[2], gainL + 2048, modL, 3, 4, XN_, SLAB_, rep ? 0 : 11, modL + 2 * 18432 + 2 * 2048, 0.5f, layer == 0, false, rep ? nullptr : DLT_); GRID_BAR(); }
            if (layer == 0) {
                if (INS(2, 5)) REPS(2) {
                    const bf16* wqkv = (const bf16*)(ws + WS_WABIN) + (size_t)1024 * 2048; const bf16* wf = (const bf16*)(ws + WS_WABIN);
                    pg8::Gemm g{XN_, wqkv, 2048, 2048, (size_t)((const char*)wf - (const char*)XN_), (size_t)((const char*)XN_ - (const char*)wqkv)};
                    pg8::ABOrder S; S.so.init(MALL, 2560, 2048, G, bx); S.G = G; S.c = bx;
                    pg8::EpiAB E{(bf16*)(ws + WS_UWL), (bf16*)(ws + WS_UWC), QB_, KB_, VB_};
                    pg8::gemm_phase<pg8::EpiAB, pg8::ABOrder, true, true>(lds, g, S, E);
                    GRID_BAR(); }
                if (INS(3, 6)) REPS(3) { qknorm_rope_phase(gw, NGW, lane, QB_, KB_, args.in[10], (const f32x2*)(ws + WS_ROPE)); fft8_prepass(lds, vcu, G, (const bf16*)(ws + WS_UWL), (bf16*)(ws + WS_DFT)); GRID_BAR(); }
                if (INS(4, 7) || (ONLY_SITE == 15 || ONLY_SITE == 16)) REPS(4) {
#ifndef PROBE_ATT
#define PROBE_ATT 3
#endif
                    if (ONLY_SITE != 15 && (!rep || (PROBE_ATT & 1))) for (int i = 0;; ++i) { const int L = i * G + vcu; if (L >= 792) break;
                        int b, hq, seq; size_t qrow; const float* ropeb;
                        if (L < 768) { b = L / 384; const int rem = L % 384; hq = rem >> 5; qrow = (size_t)b * SB + 256 + (size_t)(rem & 31) * 256; seq = SB; ropeb = (const float*)(ws + WS_ROPE) + (size_t)(rem & 31) * 256 * 128; }
                        else { const int jx = L - 768; b = jx / 12; hq = jx % 12; qrow = (size_t)b * SB; seq = 256; ropeb = nullptr; }
                        const size_t kvoff = (size_t)(b * 4 + hq / 3) * SB * 128;
                        attn::attn_dense_body<attn::bf16>((const attn::bf16*)(QB_ + qrow * 1536 + hq * 128), (const attn::bf16*)(KB_ + kvoff), (const attn::bf16*)(VB_ + kvoff), MIX_ + qrow * 2048 + 512 + hq * 128, seq, (char*)lds_raw, args.in[10], ropeb);
                        __syncthreads(); }
                    __syncthreads();
                    if (ONLY_SITE != 16 && (!rep || (PROBE_ATT & 2))) { pg8::Gemm g{(const bf16*)(ws + WS_DFTA), (const bf16*)(ws + WS_DFT), 2048, 2048, 0, 0};
                      pg8::DftOrder S{4, 32, 1, G, bx, 2048 / 64}; pg8::EpiDFT E{MIX_, 0.011048543456039806f};
                      pg8::gemm_phase<pg8::EpiDFT, pg8::DftOrder, true, true>(lds, g, S, E); }
                    if (ONLY_SITE != 16) { if (G == 256) { if (bx >= 128) ctx_dft_phase(lds, bx - 128, 128, (const bf16*)(ws + WS_UWC), MIX_); }
                                           else ctx_dft_phase(lds, vcu, G, (const bf16*)(ws + WS_UWC), MIX_); }
                    GRID_BAR(); }
            } else {
                if (INS(5, 16)) REPS(5) {
                    pg8::Gemm g{XN_, (const bf16*)(ws + WS_WHGIN), 2048, 2048, 0, 0}; pg8::StaticOrder S; S.init(MALL, 10240, 2048, G, bx);
                    pg8::EpiHG E{HG_, args.in[13]};
                    pg8::gemm_phase<pg8::EpiHG, pg8::StaticOrder, true, true>(lds, g, S, E);
                    GRID_BAR(); }
                if (INS(6, 17)) REPS(6) { hgrn_scan<false>(lds, vcu, G, HG_, USEG_, DSEG_, OFW_, OBW_, rep ? PROBE_SCAN : 0); GRID_BAR(); }
                if (INS(7, 18)) REPS(7) { hgrn_combine(vcu, G, USEG_, DSEG_); GRID_BAR(); }
                if (INS(8, 19)) REPS(8) { hgrn_scan<true>(lds, vcu, G, HG_, USEG_, DSEG_, OFW_, OBW_, rep ? PROBE_SCAN : 0); GRID_BAR(); }
                if (INS(9, 20)) REPS(9) { readout_phase(gw, NGW, lane, OFW_, OBW_, HG_, args.in[14], XN_); GRID_BAR(); }
            }
            if (INS(10, mb + (layer == 0 ? 4 : 6))) REPS(10) {
                pg8::Gemm g; int Kk; if (layer == 0) { g = pg8::Gemm{MIX_, (const bf16*)(ws + WS_WABOUT), 2048, 2048, 0, 0}; Kk = 2048; } else { g = pg8::Gemm{XN_, (const bf16*)(ws + WS_WHGOUT), 2048, 2048, 0, 0}; Kk = 2048; }
                pg8::ResidOrder S; S.so.init(MALL, 2048, Kk, G, bx, 1); S.nsl = layer == 0 ? 4 : 0;
                pg8::EpiResid E{rep ? XN_ : DLT_, modL + 5 * 2048, 1.f, SLAB_, rep};
                pg8::gemm_phase<pg8::EpiResid, pg8::ResidOrder, RES_ALIGN, true>(lds, g, S, E);
                GRID_BAR(); }
        }
        const int pb = f == 0 ? 1 : f == 1 ? 9 : f == 2 ? 12 : 22;
        const int jb = sub == 0 ? 0 : 6;
        if (INS(11, pb)) REPS(11) {
            const float* sg = f == 1 ? modL + 2 * 18432 + 5 * 2048 : MOD_ + 2 * 18432 + 8 * 2048;
            norm_phase(f == 0, gw, NGW, lane, H_, args.in[0], args.in[2], gainL + (sub == 0 ? 0 : 2) * 2048, modL, jb, jb + 1, XN_, SLAB_, rep ? 0 : f == 1 ? 4 : f == 2 ? 11 : 0, sg, f == 1 ? 1.f : 0.5f, false, f == 3, (f == 0 || rep) ? nullptr : DLT_); GRID_BAR(); }
        if (INS(12, pb + 1)) REPS(12) {
            pg8::Gemm g{XN_, (const bf16*)(ws + WS_WFIN) + (size_t)f * 11264 * 2048, 2048, 2048, 0, 0}; pg8::StaticOrder S; S.init(MALL, 11264, 2048, G, bx, f == 3);
            pg8::EpiSwiGLU E{HID_, FFD};
            pg8::gemm_phase<pg8::EpiSwiGLU, pg8::StaticOrder, FFN_ALIGN, FFN_SP2>(lds, g, S, E);
            GRID_BAR(); }
        if (INS(13, pb + 2)) REPS(13) {
            pg8::Gemm g{HID_, (const bf16*)(ws + WS_WFOUT) + (size_t)f * 2048 * FFD, 64, FFD, 0, 0, (size_t)256 * 64 * 2, (size_t)(FFD / 64) * 256 * 64 * 2};
#ifdef PROBE_SAMEA
            if (rep) g.tstA = 64;
#endif
            pg8::ResidOrder S; S.so.init(MALL, 2048, FFD, G, bx, 1); S.nsl = f == 3 ? 0 : 11;
            pg8::EpiResid E{rep ? XN_ : DLT_, modL + (jb + 2) * 2048, 0.5f, SLAB_, rep};
            pg8::gemm_phase<pg8::EpiResid, pg8::ResidOrder, RES_ALIGN, true>(lds, g, S, E);
            GRID_BAR(); }
        }
    {
        constexpr int f = 2;
        const int layer = f >> 1, sub = f & 1;
        const float* modL = MOD_ + (size_t)layer * 3 * 18432;
        const float* gainL = args.in[6] + (size_t)layer * 3 * 2048;
        if (sub == 1) {
            const int mb = layer == 0 ? 4 : 15;
            if (INS(1, mb)) REPS(1) { norm_phase(layer == 0 && !rep, gw, NGW, lane, H_, args.in[0], args.in[2], gainL + 2048, modL, 3, 4, XN_, SLAB_, rep ? 0 : 11, modL + 2 * 18432 + 2 * 2048, 0.5f, layer == 0, false, rep ? nullptr : DLT_); GRID_BAR(); }
            if (layer == 0) {
                if (INS(2, 5)) REPS(2) {
                    const bf16* wqkv = (const bf16*)(ws + WS_WABIN) + (size_t)1024 * 2048; const bf16* wf = (const bf16*)(ws + WS_WABIN);
                    pg8::Gemm g{XN_, wqkv, 2048, 2048, (size_t)((const char*)wf - (const char*)XN_), (size_t)((const char*)XN_ - (const char*)wqkv)};
                    pg8::ABOrder S; S.so.init(MALL, 2560, 2048, G, bx); S.G = G; S.c = bx;
                    pg8::EpiAB E{(bf16*)(ws + WS_UWL), (bf16*)(ws + WS_UWC), QB_, KB_, VB_};
                    pg8::gemm_phase<pg8::EpiAB, pg8::ABOrder, true, true>(lds, g, S, E);
                    GRID_BAR(); }
                if (INS(3, 6)) REPS(3) { qknorm_rope_phase(gw, NGW, lane, QB_, KB_, args.in[10], (const f32x2*)(ws + WS_ROPE)); fft8_prepass(lds, vcu, G, (const bf16*)(ws + WS_UWL), (bf16*)(ws + WS_DFT)); GRID_BAR(); }
                if (INS(4, 7) || (ONLY_SITE == 15 || ONLY_SITE == 16)) REPS(4) {
#ifndef PROBE_ATT
#define PROBE_ATT 3
#endif
                    if (ONLY_SITE != 15 && (!rep || (PROBE_ATT & 1))) for (int i = 0;; ++i) { const int L = i * G + vcu; if (L >= 792) break;
                        int b, hq, seq; size_t qrow; const float* ropeb;
                        if (L < 768) { b = L / 384; const int rem = L % 384; hq = rem >> 5; qrow = (size_t)b * SB + 256 + (size_t)(rem & 31) * 256; seq = SB; ropeb = (const float*)(ws + WS_ROPE) + (size_t)(rem & 31) * 256 * 128; }
                        else { const int jx = L - 768; b = jx / 12; hq = jx % 12; qrow = (size_t)b * SB; seq = 256; ropeb = nullptr; }
                        const size_t kvoff = (size_t)(b * 4 + hq / 3) * SB * 128;
                        attn::attn_dense_body<attn::bf16>((const attn::bf16*)(QB_ + qrow * 1536 + hq * 128), (const attn::bf16*)(KB_ + kvoff), (const attn::bf16*)(VB_ + kvoff), MIX_ + qrow * 2048 + 512 + hq * 128, seq, (char*)lds_raw, args.in[10], ropeb);
                        __syncthreads(); }
                    __syncthreads();
                    if (ONLY_SITE != 16 && (!rep || (PROBE_ATT & 2))) { pg8::Gemm g{(const bf16*)(ws + WS_DFTA), (const bf16*)(ws + WS_DFT), 2048, 2048, 0, 0};
                      pg8::DftOrder S{4, 32, 1, G, bx, 2048 / 64}; pg8::EpiDFT E{MIX_, 0.011048543456039806f};
                      pg8::gemm_phase<pg8::EpiDFT, pg8::DftOrder, true, true>(lds, g, S, E); }
                    if (ONLY_SITE != 16) { if (G == 256) { if (bx >= 128) ctx_dft_phase(lds, bx - 128, 128, (const bf16*)(ws + WS_UWC), MIX_); }
                                           else ctx_dft_phase(lds, vcu, G, (const bf16*)(ws + WS_UWC), MIX_); }
                    GRID_BAR(); }
            } else {
                if (INS(5, 16)) REPS(5) {
                    pg8::Gemm g{XN_, (const bf16*)(ws + WS_WHGIN), 2048, 2048, 0, 0}; pg8::StaticOrder S; S.init(MALL, 10240, 2048, G, bx);
                    pg8::EpiHG E{HG_, args.in[13]};
                    pg8::gemm_phase<pg8::EpiHG, pg8::StaticOrder, true, true>(lds, g, S, E);
                    GRID_BAR(); }
                if (INS(6, 17)) REPS(6) { hgrn_scan<false>(lds, vcu, G, HG_, USEG_, DSEG_, OFW_, OBW_, rep ? PROBE_SCAN : 0); GRID_BAR(); }
                if (INS(7, 18)) REPS(7) { hgrn_combine(vcu, G, USEG_, DSEG_); GRID_BAR(); }
                if (INS(8, 19)) REPS(8) { hgrn_scan<true>(lds, vcu, G, HG_, USEG_, DSEG_, OFW_, OBW_, rep ? PROBE_SCAN : 0); GRID_BAR(); }
                if (INS(9, 20)) REPS(9) { readout_phase(gw, NGW, lane, OFW_, OBW_, HG_, args.in[14], XN_); GRID_BAR(); }
            }
            if (INS(10, mb + (layer == 0 ? 4 : 6))) REPS(10) {
                pg8::Gemm g; int Kk; if (layer == 0) { g = pg8::Gemm{MIX_, (const bf16*)(ws + WS_WABOUT), 2048, 2048, 0, 0}; Kk = 2048; } else { g = pg8::Gemm{XN_, (const bf16*)(ws + WS_WHGOUT), 2048, 2048, 0, 0}; Kk = 2048; }
                pg8::ResidOrder S; S.so.init(MALL, 2048, Kk, G, bx, 1); S.nsl = layer == 0 ? 4 : 0;
                pg8::EpiResid E{rep ? XN_ : DLT_, modL + 5 * 2048, 1.f, SLAB_, rep};
                pg8::gemm_phase<pg8::EpiResid, pg8::ResidOrder, RES_ALIGN, true>(lds, g, S, E);
                GRID_BAR(); }
        }
        const int pb = f == 0 ? 1 : f == 1 ? 9 : f == 2 ? 12 : 22;
        const int jb = sub == 0 ? 0 : 6;
        if (INS(11, pb)) REPS(11) {
            const float* sg = f == 1 ? modL + 2 * 18432 + 5 * 2048 : MOD_ + 2 * 18432 + 8 * 2048;
            norm_phase(f == 0, gw, NGW, lane, H_, args.in[0], args.in[2], gainL + (sub == 0 ? 0 : 2) * 2048, modL, jb, jb + 1, XN_, SLAB_, rep ? 0 : f == 1 ? 4 : f == 2 ? 11 : 0, sg, f == 1 ? 1.f : 0.5f, false, f == 3, (f == 0 || rep) ? nullptr : DLT_); GRID_BAR(); }
        if (INS(12, pb + 1)) REPS(12) {
            pg8::Gemm g{XN_, (const bf16*)(ws + WS_WFIN) + (size_t)f * 11264 * 2048, 2048, 2048, 0, 0}; pg8::StaticOrder S; S.init(MALL, 11264, 2048, G, bx, f == 3);
            pg8::EpiSwiGLU E{HID_, FFD};
            pg8::gemm_phase<pg8::EpiSwiGLU, pg8::StaticOrder, FFN_ALIGN, FFN_SP2>(lds, g, S, E);
            GRID_BAR(); }
        if (INS(13, pb + 2)) REPS(13) {
            pg8::Gemm g{HID_, (const bf16*)(ws + WS_WFOUT) + (size_t)f * 2048 * FFD, 64, FFD, 0, 0, (size_t)256 * 64 * 2, (size_t)(FFD / 64) * 256 * 64 * 2};
#ifdef PROBE_SAMEA
            if (rep) g.tstA = 64;
#endif
            pg8::ResidOrder S; S.so.init(MALL, 2048, FFD, G, bx, 1); S.nsl = f == 3 ? 0 : 11;
            pg8::EpiResid E{rep ? XN_ : DLT_, modL + (jb + 2) * 2048, 0.5f, SLAB_, rep};
            pg8::gemm_phase<pg8::EpiResid, pg8::ResidOrder, RES_ALIGN, true>(lds, g, S, E);
            GRID_BAR(); }
        }
    {
        constexpr int f = 3;
        const int layer = f >> 1, sub = f & 1;
        const float* modL = MOD_ + (size_t)layer * 3 * 18432;
        const float* gainL = args.in[6] + (size_t)layer * 3 * 2048;
        if (sub == 1) {
            const int mb = layer == 0 ? 4 : 15;
            if (INS(1, mb)) REPS(1) { norm_phase(layer == 0 && !rep, gw, NGW, lane, H_, args.in[0], args.in[2], gainL + 2048, modL, 3, 4, XN_, SLAB_, rep ? 0 : 11, modL + 2 * 18432 + 2 * 2048, 0.5f, layer == 0, false, rep ? nullptr : DLT_); GRID_BAR(); }
            if (layer == 0) {
                if (INS(2, 5)) REPS(2) {
                    const bf16* wqkv = (const bf16*)(ws + WS_WABIN) + (size_t)1024 * 2048; const bf16* wf = (const bf16*)(ws + WS_WABIN);
                    pg8::Gemm g{XN_, wqkv, 2048, 2048, (size_t)((const char*)wf - (const char*)XN_), (size_t)((const char*)XN_ - (const char*)wqkv)};
                    pg8::ABOrder S; S.so.init(MALL, 2560, 2048, G, bx); S.G = G; S.c = bx;
                    pg8::EpiAB E{(bf16*)(ws + WS_UWL), (bf16*)(ws + WS_UWC), QB_, KB_, VB_};
                    pg8::gemm_phase<pg8::EpiAB, pg8::ABOrder, true, true>(lds, g, S, E);
                    GRID_BAR(); }
                if (INS(3, 6)) REPS(3) { qknorm_rope_phase(gw, NGW, lane, QB_, KB_, args.in[10], (const f32x2*)(ws + WS_ROPE)); fft8_prepass(lds, vcu, G, (const bf16*)(ws + WS_UWL), (bf16*)(ws + WS_DFT)); GRID_BAR(); }
                if (INS(4, 7) || (ONLY_SITE == 15 || ONLY_SITE == 16)) REPS(4) {
#ifndef PROBE_ATT
#define PROBE_ATT 3
#endif
                    if (ONLY_SITE != 15 && (!rep || (PROBE_ATT & 1))) for (int i = 0;; ++i) { const int L = i * G + vcu; if (L >= 792) break;
                        int b, hq, seq; size_t qrow; const float* ropeb;
                        if (L < 768) { b = L / 384; const int rem = L % 384; hq = rem >> 5; qrow = (size_t)b * SB + 256 + (size_t)(rem & 31) * 256; seq = SB; ropeb = (const float*)(ws + WS_ROPE) + (size_t)(rem & 31) * 256 * 128; }
                        else { const int jx = L - 768; b = jx / 12; hq = jx % 12; qrow = (size_t)b * SB; seq = 256; ropeb = nullptr; }
                        const size_t kvoff = (size_t)(b * 4 + hq / 3) * SB * 128;
                        attn::attn_dense_body<attn::bf16>((const attn::bf16*)(QB_ + qrow * 1536 + hq * 128), (const attn::bf16*)(KB_ + kvoff), (const attn::bf16*)(VB_ + kvoff), MIX_ + qrow * 2048 + 512 + hq * 128, seq, (char*)lds_raw, args.in[10], ropeb);
                        __syncthreads(); }
                    __syncthreads();
                    if (ONLY_SITE != 16 && (!rep || (PROBE_ATT & 2))) { pg8::Gemm g{(const bf16*)(ws + WS_DFTA), (const bf16*)(ws + WS_DFT), 2048, 2048, 0, 0};
                      pg8::DftOrder S{4, 32, 1, G, bx, 2048 / 64}; pg8::EpiDFT E{MIX_, 0.011048543456039806f};
                      pg8::gemm_phase<pg8::EpiDFT, pg8::DftOrder, true, true>(lds, g, S, E); }
                    if (ONLY_SITE != 16) { if (G == 256) { if (bx >= 128) ctx_dft_phase(lds, bx - 128, 128, (const bf16*)(ws + WS_UWC), MIX_); }
                                           else ctx_dft_phase(lds, vcu, G, (const bf16*)(ws + WS_UWC), MIX_); }
                    GRID_BAR(); }
            } else {
                if (INS(5, 16)) REPS(5) {
                    pg8::Gemm g{XN_, (const bf16*)(ws + WS_WHGIN), 2048, 2048, 0, 0}; pg8::StaticOrder S; S.init(MALL, 10240, 2048, G, bx);
                    pg8::EpiHG E{HG_, args.in[13]};
                    pg8::gemm_phase<pg8::EpiHG, pg8::StaticOrder, true, true>(lds, g, S, E);
                    GRID_BAR(); }
                if (INS(6, 17)) REPS(6) { hgrn_scan<false>(lds, vcu, G, HG_, USEG_, DSEG_, OFW_, OBW_, rep ? PROBE_SCAN : 0); GRID_BAR(); }
                if (INS(7, 18)) REPS(7) { hgrn_combine(vcu, G, USEG_, DSEG_); GRID_BAR(); }
                if (INS(8, 19)) REPS(8) { hgrn_scan<true>(lds, vcu, G, HG_, USEG_, DSEG_, OFW_, OBW_, rep ? PROBE_SCAN : 0); GRID_BAR(); }
                if (INS(9, 20)) REPS(9) { readout_phase(gw, NGW, lane, OFW_, OBW_, HG_, args.in[14], XN_); GRID_BAR(); }
            }
            if (INS(10, mb + (layer == 0 ? 4 : 6))) REPS(10) {
                pg8::Gemm g; int Kk; if (layer == 0) { g = pg8::Gemm{MIX_, (const bf16*)(ws + WS_WABOUT), 2048, 2048, 0, 0}; Kk = 2048; } else { g = pg8::Gemm{XN_, (const bf16*)(ws + WS_WHGOUT), 2048, 2048, 0, 0}; Kk = 2048; }
                pg8::ResidOrder S; S.so.init(MALL, 2048, Kk, G, bx, 1); S.nsl = layer == 0 ? 4 : 0;
                pg8::EpiResid E{rep ? XN_ : DLT_, modL + 5 * 2048, 1.f, SLAB_, rep};
                pg8::gemm_phase<pg8::EpiResid, pg8::ResidOrder, RES_ALIGN, true>(lds, g, S, E);
                GRID_BAR(); }
        }
        const int pb = f == 0 ? 1 : f == 1 ? 9 : f == 2 ? 12 : 22;
        const int jb = sub == 0 ? 0 : 6;
        if (INS(11, pb)) REPS(11) {
            const float* sg = f == 1 ? modL + 2 * 18432 + 5 * 2048 : MOD_ + 2 * 18432 + 8 * 2048;
            norm_phase(f == 0, gw, NGW, lane, H_, args.in[0], args.in[2], gainL + (sub == 0 ? 0 : 2) * 2048, modL, jb, jb + 1, XN_, SLAB_, rep ? 0 : f == 1 ? 4 : f == 2 ? 11 : 0, sg, f == 1 ? 1.f : 0.5f, false, f == 3, (f == 0 || rep) ? nullptr : DLT_); GRID_BAR(); }
        if (INS(12, pb + 1)) REPS(12) {
            pg8::Gemm g{XN_, (const bf16*)(ws + WS_WFIN) + (size_t)f * 11264 * 2048, 2048, 2048, 0, 0}; pg8::StaticOrder S; S.init(MALL, 11264, 2048, G, bx, f == 3);
            pg8::EpiSwiGLU E{HID_, FFD};
            pg8::gemm_phase<pg8::EpiSwiGLU, pg8::StaticOrder, FFN_ALIGN, FFN_SP2>(lds, g, S, E);
            GRID_BAR(); }
        if (INS(13, pb + 2)) REPS(13) {
            pg8::Gemm g{HID_, (const bf16*)(ws + WS_WFOUT) + (size_t)f * 2048 * FFD, 64, FFD, 0, 0, (size_t)256 * 64 * 2, (size_t)(FFD / 64) * 256 * 64 * 2};
#ifdef PROBE_SAMEA
            if (rep) g.tstA = 64;
#endif
            pg8::ResidOrder S; S.so.init(MALL, 2048, FFD, G, bx, 1); S.nsl = f == 3 ? 0 : 11;
            pg8::EpiResid E{rep ? XN_ : DLT_, modL + (jb + 2) * 2048, 0.5f, SLAB_, rep};
            pg8::gemm_phase<pg8::EpiResid, pg8::ResidOrder, RES_ALIGN, true>(lds, g, S, E);
            GRID_BAR(); }
        }
#ifdef PROBE_BARS
    for (int q = 0; q < PROBE_BARS; ++q) GRID_BAR();
#endif
    if (INS(14, 25)) REPS(14) final_phase(gw, NGW, lane, H_, args.in[16], args.out, DLT_);
#undef INS
#undef GRID_BAR
}

extern "C" void kernel_launch(void* const* d_in, const int* in_sizes, int n_in, void* d_out, int out_size, void* d_ws, size_t ws_size, hipStream_t stream) {
    static int grid = 0;
    if (grid == 0) {
        if (n_in != 17 || in_sizes[0] != NBATCH * SEQ * DM || out_size != NBATCH * SEQ * DM || ws_size < WS_END) {
            fprintf(stderr, "kernel_launch: shape mismatch: n_in %d in0 %d out %d ws %zu (need %zu); nothing launched\n", n_in, n_in > 0 ? in_sizes[0] : -1, out_size, ws_size, (size_t)WS_END); grid = -1; return; }
        int dev = 0, cus = 0, per_cu = 0;
        if (hipGetDevice(&dev) != hipSuccess || hipDeviceGetAttribute(&cus, hipDeviceAttributeMultiprocessorCount, dev) != hipSuccess) { grid = -1; return; }
        if (hipFuncSetAttribute((const void*)mk_fwd, hipFuncAttributeMaxDynamicSharedMemorySize, LDS_BYTES) != hipSuccess) { fprintf(stderr, "kernel_launch: hipFuncSetAttribute(%d) failed\n", LDS_BYTES); grid = -1; return; }
        if (hipOccupancyMaxActiveBlocksPerMultiprocessor(&per_cu, (const void*)mk_fwd, NWAVES * 64, LDS_BYTES) != hipSuccess || per_cu < 1)
            fprintf(stderr, "kernel_launch: note: occupancy query reports %d workgroups per CU\n", per_cu);
        (void)hipGetLastError();
        grid = cus;
    }
    if (grid < 0) return;
    if (hipMemsetAsync((char*)d_ws + WS_CTL, 0, CTL_ZERO_BYTES, stream) != hipSuccess) { fprintf(stderr, "kernel_launch: memset failed\n"); return; }
    Args a{};
    for (int i = 0; i < 17; ++i) a.in[i] = (const float*)d_in[i];
    a.out = (float*)d_out; a.ws = (unsigned char*)d_ws;
#if MK_SPLIT
    for (int ph = 0; ph < NPH; ++ph) { a.ph_lo = ph; a.ph_hi = ph + 1; hipLaunchKernelGGL(mk_fwd, dim3(grid), dim3(NWAVES * 64), LDS_BYTES, stream, a); }
#else
    a.ph_lo = 0; a.ph_hi = NPH; hipLaunchKernelGGL(mk_fwd, dim3(grid), dim3(NWAVES * 64), LDS_BYTES, stream, a);
#endif
    const hipError_t le = hipPeekAtLastError();
    if (le != hipSuccess) fprintf(stderr, "kernel_launch: launch failed: %s\n", hipGetErrorName(le));
}
```

```cpp
#include <hip/hip_runtime.h>
#include <hip/hip_bf16.h>
#include <cstdio>
#include <cstdint>
#ifndef MK_SPLIT
#define MK_SPLIT 0
#endif
namespace pg8 {
#define PG8_LAS __attribute__((address_space(3)))
typedef unsigned short bf16_t;
typedef short bf16x8 __attribute__((ext_vector_type(8)));
typedef float f32x4 __attribute__((ext_vector_type(4)));
typedef unsigned u32x4 __attribute__((ext_vector_type(4)));
constexpr int BM = 256, BK = 64, HALF = 128, HTB = HALF * BK * 2  , STAGE_BYTES = 8 * HTB, NXCD = 8, WGM = 8;
__host__ __device__ __forceinline__ int lds_byte(int r, int c) { const int st = (r >> 4) * 2 + (c >> 5), rr = r & 15, cc = c & 31, ob = rr * 64 + cc * 2; return st * 1024 + (ob ^ (((ob >> 9) & 1) << 5)); }
__host__ __device__ __forceinline__ void stage_rc(int b, int& R, int& C) { const int st = b / 1024, sb = b % 1024, swz = sb ^ (((sb >> 9) & 1) << 5); R = (st >> 1) * 16 + swz / 64; C = (st & 1) * 32 + (swz % 64) / 2; }
__host__ __device__ __forceinline__ int perm32(int rho) { const int n = rho >> 4, i = rho & 15; return 8 * (i >> 2) + 4 * n + (i & 3); }

struct Unit { int pm, pn, z, k0, nt; };
struct Gemm { const bf16_t* A; const bf16_t* Bt; int lda, ldb; size_t azs, bzs, kstA = 0, tstA = 0; };

constexpr int SB_ = 8448, PPB = 33;
struct StaticOrder {
    int nM, nN, nwg, G, c, ntk, latonly, wgm;
    __host__ __device__ void init(int M, int N, int K, int G_, int c_, int latonly_ = 0, int wgm_ = WGM) { nM = latonly_ ? 64 : M / BM; nN = N / BM; nwg = nM * nN; G = G_; c = c_; ntk = K / BK; latonly = latonly_; wgm = wgm_; }
    __host__ __device__ bool next(int i, Unit& u) const {
        const long L = (long)i * G + c; if (L >= nwg) return false;
#if defined(__HIP_DEVICE_COMPILE__)
        int nN = this->nN, nM = this->nM, nwg = this->nwg; asm volatile("" : "+s"(nN), "+s"(nM), "+s"(nwg));
#endif
        int wgid = (int)L; { const int q = nwg / NXCD, r = nwg % NXCD, xcd = wgid % NXCD, off = wgid / NXCD; wgid = (xcd < r ? xcd * (q + 1) : r * (q + 1) + (xcd - r) * q) + off; }
        const int nig = wgm * nN, gid = wgid / nig, fm = gid * wgm, gsz = (nM - fm) < wgm ? (nM - fm) : wgm;
        u.pm = fm + ((wgid % nig) % gsz); u.pn = (wgid % nig) / gsz; u.z = 0; u.k0 = 0; u.nt = ntk;
        if (latonly) u.pm += 1 + (u.pm >= 32 ? 1 : 0);
        return true;
    }
    __device__ __forceinline__ void a_ready(const Unit&) const {}
    __device__ __forceinline__ void done(const Unit&) const {}
};
struct ResidOrder {
    StaticOrder so; int nsl;
    __device__ bool next(int i, Unit& u) const {
        const int c = so.c, has = c < 16 * nsl, first = has && !(c & 1);
        if (first) { if (i == 0) { slab(c, u); return true; } return so.next(i - 1, u); }
        if (so.next(i, u)) return true;
        const long L = (long)i * so.G + c; if (has && L >= so.nwg && L - so.G < so.nwg) { slab(c, u); return true; }
        return false;
    }
    __device__ void slab(int L, Unit& u) const { const int tile = L & 15, sl = L >> 4; u.pm = (tile >> 3) * PPB; u.pn = tile & 7; u.z = 1; u.k0 = sl * 512; u.nt = 8; }
    __device__ __forceinline__ void a_ready(const Unit&) const {}
    __device__ __forceinline__ void done(const Unit&) const {}
};
struct DftOrder {
    int nM, nN, nz, G, c, ntk;
    __device__ bool next(int i, Unit& u) const {
        const int L = i * G + c; if (L >= nM * nN * nz) return false;
        const int per = nM * nN; u.z = L / per; const int r = L % per; u.pm = r / nN; u.pn = r % nN; u.k0 = 0; u.nt = ntk; return true;
    }
    __device__ __forceinline__ void a_ready(const Unit&) const {}
    __device__ __forceinline__ void done(const Unit&) const {}
};
__device__ __forceinline__ unsigned cvt_pk_bf16(float lo, float hi) { unsigned r; asm volatile("v_cvt_pk_bf16_f32 %0, %1, %2" : "=v"(r) : "v"(lo), "v"(hi)); return r; }
__device__ __forceinline__ float fast_sigmoid(float x) { return __builtin_amdgcn_rcpf(1.f + __builtin_amdgcn_exp2f(-1.4426950408889634f * x)); }

struct EpiSwiGLU {
    static constexpr bool PERM = true, AFTER_DRAIN = false;
    bf16_t* O; int ldc;
    __device__ __forceinline__ void operator()(const f32x4 (&acc)[2][2][4][2], const Unit& u, int wr, int wc, int fr, int fq) const {
        const int row0 = u.pm * BM + wr * 64 + fr, col0 = u.pn * HALF + wc * 32 + 8 * fq;
#pragma unroll
        for (int ai = 0; ai < 2; ++ai)
#pragma unroll
            for (int m = 0; m < 4; ++m) {
                float a[8], e[8];
#pragma unroll
                for (int q = 0; q < 8; ++q) a[q] = acc[ai][0][m][q >> 2][q & 3];
#pragma unroll
                for (int q = 0; q < 8; ++q) e[q] = __builtin_amdgcn_exp2f(-a[q]);
#pragma unroll
                for (int q = 0; q < 8; ++q) e[q] += 1.f;
#pragma unroll
                for (int q = 0; q < 8; ++q) e[q] = __builtin_amdgcn_rcpf(e[q]);
#pragma unroll
                for (int q = 0; q < 8; ++q) a[q] = a[q] * acc[ai][1][m][q >> 2][q & 3] * e[q];
                u32x4 w; w.x = cvt_pk_bf16(a[0], a[1]); w.y = cvt_pk_bf16(a[2], a[3]); w.z = cvt_pk_bf16(a[4], a[5]); w.w = cvt_pk_bf16(a[6], a[7]);
                const int row = row0 + ai * HALF + m * 16;
                *(u32x4*)(O + (((size_t)(row >> 8) * (ldc >> 6) + (col0 >> 6)) * 256 + (row & 255)) * 64 + (col0 & 63)) = w; }
    }
};
struct EpiResid {
    static constexpr bool PERM = true, AFTER_DRAIN = false;
    bf16_t* D; const float* gate; float coef; float* SLAB; int probe_rep;
    __device__ __forceinline__ void operator()(const f32x4 (&acc)[2][2][4][2], const Unit& u, int wr, int wc, int fr, int fq) const {
#ifdef PROBE_SKIP_EPI
        if (probe_rep) return;
#endif
        const int b = u.pm / PPB, pp = u.pm % PPB, mrow = pp == 0 ? 2 : b;
        const int rloc0 = wr * 64 + fr, col0 = u.pn * BM + wc * 32 + 8 * fq;
        if (u.z) {
            float* sp = SLAB + ((size_t)(u.k0 >> 9) * 512 + b * 256) * 2048;
#pragma unroll
            for (int ai = 0; ai < 2; ++ai)
#pragma unroll
                for (int m = 0; m < 4; ++m) { float* dp = sp + (size_t)(rloc0 + ai * HALF + m * 16) * 2048 + col0;
#pragma unroll
                    for (int bj = 0; bj < 2; ++bj)
#pragma unroll
                        for (int n = 0; n < 2; ++n) *(f32x4*)(dp + bj * HALF + 4 * n) = acc[ai][bj][m][n]; }
            return;
        }
        const float* gp = gate + (size_t)mrow * 18432 + col0;
        f32x4 gv[2][2];
#pragma unroll
        for (int bj = 0; bj < 2; ++bj)
#pragma unroll
            for (int n = 0; n < 2; ++n) gv[bj][n] = *(const f32x4*)(gp + bj * HALF + 4 * n) * coef;
        bf16_t* dbase = D + ((size_t)u.pm * BM + rloc0) * 2048 + col0;
#pragma unroll
        for (int ai = 0; ai < 2; ++ai)
#pragma unroll
            for (int m = 0; m < 4; ++m)
#pragma unroll
                for (int bj = 0; bj < 2; ++bj) { const f32x4 v0 = gv[bj][0] * acc[ai][bj][m][0], v1 = gv[bj][1] * acc[ai][bj][m][1];
                    u32x4 w; w.x = cvt_pk_bf16(v0[0], v0[1]); w.y = cvt_pk_bf16(v0[2], v0[3]); w.z = cvt_pk_bf16(v1[0], v1[1]); w.w = cvt_pk_bf16(v1[2], v1[3]);
                    *(u32x4*)(dbase + (size_t)(ai * HALF + m * 16) * 2048 + bj * HALF) = w; }
    }
};
struct ABOrder {
    StaticOrder so; int G, c;
    __device__ bool next(int i, Unit& u) const {
        if (so.next(i, u)) return true;
        const int L = i * G + c - so.nwg; if (L >= 4 * 66) return false;
        u.z = 1; u.pm = L & 3; u.pn = L >> 2; u.k0 = 0; u.nt = so.ntk; return true;
    }
    __device__ __forceinline__ void a_ready(const Unit&) const {}
    __device__ __forceinline__ void done(const Unit&) const {}
};
struct EpiAB {
    static constexpr bool PERM = true, AFTER_DRAIN = false;
    bf16_t *UWL, *UWC, *Q, *Kb, *Vb;
    __device__ __forceinline__ void operator()(const f32x4 (&acc)[2][2][4][2], const Unit& u, int wr, int wc, int fr, int fq) const {
        bf16_t* base; size_t ldc, bjs = HALF; int col0;
        if (u.z == 0) {
            if (u.pn < 6) { base = Q + (size_t)u.pm * BM * 1536; ldc = 1536; col0 = u.pn * BM + wc * 32 + 8 * fq; }
            else {
                const int b = u.pm / PPB, pp = u.pm % PPB, ct = (u.pn - 6) & 1;
                base = (u.pn < 8 ? Kb : Vb) + ((size_t)(b * 4 + ct * 2) * SB_ + (size_t)pp * 256) * 128; ldc = 128; bjs = (size_t)SB_ * 128; col0 = wc * 32 + 8 * fq; }
        } else {
            const int b = u.pn / PPB, pp = u.pn % PPB, part = u.pm >> 1;
            const size_t r0 = (size_t)part * 1024 + b * 512 + (u.pm & 1) * 256;
            if (pp == 0) { base = UWC + r0 * 256; ldc = 256; col0 = wc * 32 + 8 * fq; } else { base = UWL + r0 * 8192; ldc = 8192; col0 = (pp - 1) * 256 + wc * 32 + 8 * fq; }
        }
        const int rloc0 = wr * 64 + fr;
#pragma unroll
        for (int ai = 0; ai < 2; ++ai)
#pragma unroll
            for (int m = 0; m < 4; ++m) { bf16_t* rowp = base + (size_t)(rloc0 + ai * HALF + m * 16) * ldc + col0;
#pragma unroll
                for (int bj = 0; bj < 2; ++bj) { const f32x4 v0 = acc[ai][bj][m][0], v1 = acc[ai][bj][m][1];
                    u32x4 w; w.x = cvt_pk_bf16(v0[0], v0[1]); w.y = cvt_pk_bf16(v0[2], v0[3]); w.z = cvt_pk_bf16(v1[0], v1[1]); w.w = cvt_pk_bf16(v1[2], v1[3]);
                    *(u32x4*)(rowp + bj * bjs) = w; } }
    }
};
struct EpiDFT {
    static constexpr bool PERM = true, AFTER_DRAIN = false;
    bf16_t* MIX; float scale;
    __device__ __forceinline__ void operator()(const f32x4 (&acc)[2][2][4][2], const Unit& u, int wr, int wc, int fr, int fq) const {
        const int kap = u.pn >> 2, b = (u.pn >> 1) & 1, col0 = (u.pn & 1) * 256 + wc * 32 + 8 * fq;
#pragma unroll
        for (int ai = 0; ai < 2; ++ai)
#pragma unroll
            for (int m = 0; m < 4; ++m) { const int kp = u.pm * BM + wr * 64 + fr + ai * HALF + m * 16; bf16_t* rowp = MIX + ((size_t)b * SB_ + 256 + 8 * kp + kap) * 2048 + col0;
#pragma unroll
                for (int bj = 0; bj < 2; ++bj) { const f32x4 v0 = acc[ai][bj][m][0] * scale, v1 = acc[ai][bj][m][1] * scale;
                    u32x4 w; w.x = cvt_pk_bf16(v0[0], v0[1]); w.y = cvt_pk_bf16(v0[2], v0[3]); w.z = cvt_pk_bf16(v1[0], v1[1]); w.w = cvt_pk_bf16(v1[2], v1[3]);
                    *(u32x4*)(rowp + bj * HALF) = w; } }
    }
};
struct EpiHG {
    static constexpr bool PERM = true, AFTER_DRAIN = false;
    bf16_t* O; const float* lbl;
    __device__ __forceinline__ void operator()(const f32x4 (&acc)[2][2][4][2], const Unit& u, int wr, int wc, int fr, int fq) const {
        const int sec = u.pn >> 3, row0 = u.pm * BM + wr * 64 + fr, col0 = u.pn * BM + wc * 32 + 8 * fq, cs0 = (u.pn & 7) * BM + wc * 32 + 8 * fq;
        float lb[2][8];
        if (sec == 1 || sec == 2) {
#pragma unroll
            for (int bj = 0; bj < 2; ++bj)
#pragma unroll
                for (int e = 0; e < 8; ++e) { const int c = cs0 + bj * HALF + e; lb[bj][e] = fast_sigmoid(lbl[2048 + c] - lbl[c]); }
        }
#pragma unroll
        for (int ai = 0; ai < 2; ++ai)
#pragma unroll
            for (int m = 0; m < 4; ++m) { bf16_t* rowp = O + ((size_t)(u.pn * 2) * 16896 + (row0 + ai * HALF + m * 16)) * 128 + wc * 32 + 8 * fq;
#pragma unroll
                for (int bj = 0; bj < 2; ++bj) { float v[8];
#pragma unroll
                    for (int e = 0; e < 8; ++e) v[e] = acc[ai][bj][m][e >> 2][e & 3];
                    u32x4 w;
                    if (sec == 1 || sec == 2) { unsigned q[8];
#pragma unroll
                        for (int e = 0; e < 8; ++e) { const float f = lb[bj][e] + (1.f - lb[bj][e]) * fast_sigmoid(v[e]); float t = fminf(fmaxf(f * 65535.f, 0.f), 65535.f); q[e] = (unsigned)__builtin_rintf(t); }
                        w.x = q[0] | (q[1] << 16); w.y = q[2] | (q[3] << 16); w.z = q[4] | (q[5] << 16); w.w = q[6] | (q[7] << 16);
                    } else {
                        if (sec == 0) {
#pragma unroll
                            for (int e = 0; e < 8; ++e) v[e] = v[e] * fast_sigmoid(v[e]);
                        } else if (sec == 4) {
#pragma unroll
                            for (int e = 0; e < 8; ++e) v[e] = fast_sigmoid(v[e]);
                        }
                        w.x = cvt_pk_bf16(v[0], v[1]); w.y = cvt_pk_bf16(v[2], v[3]); w.z = cvt_pk_bf16(v[4], v[5]); w.w = cvt_pk_bf16(v[6], v[7]);
                    }
                    *(u32x4*)(rowp + (size_t)bj * 16896 * 128) = w; } }
    }
};
template <class Epi, class Sched, bool ALIGN_EPI = false, bool SP2 = false>
__device__ __forceinline__ void gemm_phase(PG8_LAS unsigned char* lds, const Gemm g, const Sched& S, const Epi& E) {
    int tid_o = threadIdx.x; asm volatile("" : "+v"(tid_o));
    const int tid = tid_o, wid = __builtin_amdgcn_readfirstlane(tid >> 6), lane = tid & 63, wr = wid >> 2, wc = wid & 3, fr = lane & 15, fq = lane >> 4;
    unsigned voffA[2], voffB[2];
#pragma unroll
    for (int i = 0; i < 2; ++i) { int R, C; stage_rc(tid * 16 + i * 8192, R, C); const int Rb = Epi::PERM ? ((R & ~31) + perm32(R & 31)) : R;
        voffA[i] = (unsigned)(R * g.lda + C) * 2u; voffB[i] = (unsigned)(Rb * g.ldb + C) * 2u; }
    const size_t kstep = (size_t)(BK * 2);
    const size_t kstA = g.kstA ? g.kstA : kstep;
    const size_t hstepA = (size_t)HALF * g.lda * 2, hstepB = (size_t)HALF * g.ldb * 2;
    const size_t tstepA = g.tstA ? g.tstA : 2 * hstepA, tstepB = 2 * hstepB;
    const unsigned ldsw = (unsigned)wid * 1024u;
    const int aoff = lds_byte(wr * 64 + fr, fq * 8), boff = lds_byte(wc * 32 + fr, fq * 8);
#define PG8_SA(b, h) (((b) * 2 + (h)) * HTB)
#define PG8_SB(b, h) ((4 + (b) * 2 + (h)) * HTB)
#define PG8_STAGE(bufoff, gbase, voff) do { _Pragma("unroll") for (int _i = 0; _i < 2; ++_i) \
        __builtin_amdgcn_global_load_lds((const unsigned*)((const char*)(gbase) + (voff)[_i]), (PG8_LAS unsigned*)(lds + (bufoff) + ldsw + _i * 8192), 16, 0, 0); } while (0)
#define PG8_LDA(dst, b, h) do { _Pragma("unroll") for (int m = 0; m < 4; ++m) _Pragma("unroll") for (int k = 0; k < 2; ++k) dst[m][k] = *(const PG8_LAS bf16x8*)(lds + PG8_SA(b, h) + aoff + m * 2048 + k * 1024); } while (0)
#define PG8_LDB(dst, b, h) do { _Pragma("unroll") for (int n = 0; n < 2; ++n) _Pragma("unroll") for (int k = 0; k < 2; ++k) dst[n][k] = *(const PG8_LAS bf16x8*)(lds + PG8_SB(b, h) + boff + n * 2048 + k * 1024); } while (0)
#define PG8_MMA(ai, bj, At, Bt) do { __builtin_amdgcn_s_setprio(1); _Pragma("unroll") for (int m = 0; m < 4; ++m) _Pragma("unroll") for (int n = 0; n < 2; ++n) _Pragma("unroll") for (int k = 0; k < 2; ++k) \
        acc[ai][bj][m][n] = __builtin_amdgcn_mfma_f32_16x16x32_bf16(Bt[n][k], At[m][k], acc[ai][bj][m][n], 0, 0, 0); __builtin_amdgcn_s_setprio(0); } while (0)
#define PG8_WAIT_V(n) asm volatile("s_waitcnt vmcnt(" #n ")" ::: "memory")
#define PG8_WAIT_L(n) asm volatile("s_waitcnt lgkmcnt(" #n ")" ::: "memory")
#define PG8_BAR __builtin_amdgcn_s_barrier()
#define PG8_SCHED __builtin_amdgcn_sched_barrier(0)
    Unit cur, nxt; int ui = 0;
    if (!S.next(0, cur)) return;
    f32x4 acc[2][2][4][2];
#pragma unroll
    for (int a = 0; a < 2; ++a)
#pragma unroll
        for (int b = 0; b < 2; ++b)
#pragma unroll
            for (int m = 0; m < 4; ++m)
#pragma unroll
                for (int n = 0; n < 2; ++n) acc[a][b][m][n] = (f32x4){0.f, 0.f, 0.f, 0.f};
    bf16x8 At[4][2], B0[2][2], B1[2][2];
    const char* cA = (const char*)g.A + (size_t)cur.pm * tstepA + (size_t)cur.z * g.azs + (size_t)(cur.k0 >> 6) * kstA; const char* cB = (const char*)g.Bt + (size_t)cur.pn * tstepB + (size_t)cur.z * g.bzs + (size_t)cur.k0 * 2;
    S.a_ready(cur);
    if constexpr (SP2) {
        PG8_STAGE(PG8_SB(0, 0), cB, voffB); PG8_STAGE(PG8_SB(0, 1), cB + hstepB, voffB); PG8_STAGE(PG8_SA(0, 0), cA, voffA); PG8_STAGE(PG8_SA(0, 1), cA + hstepA, voffA);
        if (wr == 1) PG8_BAR;
        PG8_WAIT_V(2); PG8_BAR;
        PG8_STAGE(PG8_SB(1, 0), cB + kstep, voffB); PG8_STAGE(PG8_SA(1, 0), cA + kstA, voffA); PG8_STAGE(PG8_SB(1, 1), cB + hstepB + kstep, voffB);
        PG8_WAIT_V(6); PG8_BAR;
    } else {
        PG8_STAGE(PG8_SB(0, 0), cB, voffB); PG8_STAGE(PG8_SA(0, 0), cA, voffA); PG8_STAGE(PG8_SB(0, 1), cB + hstepB, voffB); PG8_STAGE(PG8_SA(0, 1), cA + hstepA, voffA);
        if (wr == 1) PG8_BAR;
        PG8_WAIT_V(4); PG8_BAR;
        PG8_STAGE(PG8_SB(1, 0), cB + kstep, voffB); PG8_STAGE(PG8_SA(1, 0), cA + kstA, voffA); PG8_STAGE(PG8_SB(1, 1), cB + hstepB + kstep, voffB);
        PG8_WAIT_V(6); PG8_BAR;
    }
    for (;;) {
        const bool has_next = S.next(ui + 1, nxt);
        const char* nA = has_next ? (const char*)g.A + (size_t)nxt.pm * tstepA + (size_t)nxt.z * g.azs + (size_t)(nxt.k0 >> 6) * kstA : cA; const char* nB = has_next ? (const char*)g.Bt + (size_t)nxt.pn * tstepB + (size_t)nxt.z * g.bzs + (size_t)nxt.k0 * 2 : cB;
        const int nt = cur.nt;
        for (int t = 0; t < nt; t += 2) {
            const bool last = (t == nt - 2);
            const char* a1 = cA + (size_t)(t + 1) * kstA;
            const char* a2 = last ? nA : cA + (size_t)(t + 2) * kstA; const char* b2 = last ? nB : cB + (size_t)(t + 2) * kstep;
            const char* a3 = a2 + kstA; const char* b3 = b2 + kstep;
            if (last && has_next) S.a_ready(nxt);
            if constexpr (SP2) {
            PG8_LDB(B0, 0, 0); PG8_LDB(B1, 0, 1); PG8_SCHED; PG8_LDA(At, 0, 0); PG8_STAGE(PG8_SA(1, 1), a1 + hstepA, voffA);
            PG8_WAIT_V(8); PG8_WAIT_L(0); PG8_BAR; PG8_MMA(0, 0, At, B0); PG8_MMA(0, 1, At, B1); PG8_BAR; PG8_SCHED;
            PG8_LDA(At, 0, 1); PG8_STAGE(PG8_SB(0, 0), b2, voffB); PG8_STAGE(PG8_SB(0, 1), b2 + hstepB, voffB); PG8_STAGE(PG8_SA(0, 0), a2, voffA);
            PG8_WAIT_V(8); PG8_WAIT_L(0); PG8_BAR; PG8_MMA(1, 0, At, B0); PG8_MMA(1, 1, At, B1); PG8_BAR; PG8_SCHED;
            PG8_LDB(B0, 1, 0); PG8_LDB(B1, 1, 1); PG8_SCHED; PG8_LDA(At, 1, 0); PG8_STAGE(PG8_SA(0, 1), a2 + hstepA, voffA);
            PG8_WAIT_V(8); PG8_WAIT_L(0); PG8_BAR; PG8_MMA(0, 0, At, B0); PG8_MMA(0, 1, At, B1); PG8_BAR; PG8_SCHED;
            PG8_LDA(At, 1, 1); PG8_STAGE(PG8_SB(1, 0), b3, voffB); PG8_STAGE(PG8_SB(1, 1), b3 + hstepB, voffB); PG8_STAGE(PG8_SA(1, 0), a3, voffA);
            PG8_WAIT_V(8); PG8_WAIT_L(0); PG8_BAR; PG8_MMA(1, 0, At, B0); PG8_MMA(1, 1, At, B1); PG8_BAR; PG8_SCHED;
            } else {
            PG8_LDB(B0, 0, 0); PG8_SCHED; PG8_LDA(At, 0, 0); PG8_STAGE(PG8_SA(1, 1), a1 + hstepA, voffA);
            PG8_WAIT_L(8); PG8_BAR; PG8_WAIT_L(0); PG8_MMA(0, 0, At, B0); PG8_BAR; PG8_SCHED;
            PG8_LDB(B1, 0, 1); PG8_STAGE(PG8_SB(0, 0), b2, voffB);
            PG8_BAR; PG8_WAIT_L(0); PG8_MMA(0, 1, At, B1); PG8_BAR;
            PG8_LDA(At, 0, 1); PG8_STAGE(PG8_SA(0, 0), a2, voffA);
            PG8_BAR; PG8_WAIT_L(0); PG8_MMA(1, 0, At, B0); PG8_BAR; PG8_SCHED;
            PG8_STAGE(PG8_SB(0, 1), b2 + hstepB, voffB);
            PG8_WAIT_V(6); PG8_BAR; PG8_MMA(1, 1, At, B1); PG8_BAR;
            PG8_LDB(B0, 1, 0); PG8_SCHED; PG8_LDA(At, 1, 0); PG8_STAGE(PG8_SA(0, 1), a2 + hstepA, voffA);
            PG8_WAIT_L(8); PG8_BAR; PG8_WAIT_L(0); PG8_MMA(0, 0, At, B0); PG8_BAR; PG8_SCHED;
            PG8_LDB(B1, 1, 1); PG8_STAGE(PG8_SB(1, 0), b3, voffB);
            PG8_BAR; PG8_WAIT_L(0); PG8_MMA(0, 1, At, B1); PG8_BAR;
            PG8_LDA(At, 1, 1); PG8_STAGE(PG8_SA(1, 0), a3, voffA);
            PG8_BAR; PG8_WAIT_L(0); PG8_MMA(1, 0, At, B0); PG8_BAR; PG8_SCHED;
            PG8_STAGE(PG8_SB(1, 1), b3 + hstepB, voffB);
            PG8_WAIT_V(6); PG8_BAR; PG8_MMA(1, 1, At, B1); PG8_BAR;
            }
        }
        if constexpr (ALIGN_EPI) { if (wr == 0) PG8_BAR; }
        if constexpr (!Epi::AFTER_DRAIN) { E(acc, cur, wr, wc, fr, fq); S.done(cur); }
        if (!has_next) break;
#pragma unroll
        for (int a = 0; a < 2; ++a)
#pragma unroll
            for (int b = 0; b < 2; ++b)
#pragma unroll
                for (int m = 0; m < 4; ++m)
#pragma unroll
                    for (int n = 0; n < 2; ++n) acc[a][b][m][n] = (f32x4){0.f, 0.f, 0.f, 0.f};
        cur = nxt; cA = nA; cB = nB; ++ui;
        if constexpr (ALIGN_EPI) { if (wr == 1) PG8_BAR; }
    }
    PG8_WAIT_V(0);
    if constexpr (!ALIGN_EPI) { if (wr == 0) PG8_BAR; }
    PG8_BAR;
    if constexpr (Epi::AFTER_DRAIN) { E.fused(acc, cur, wr, wc, fr, fq, lds, wid, lane); S.done(cur); }
#undef PG8_SA
#undef PG8_SB
#undef PG8_STAGE
#undef PG8_LDA
#undef PG8_LDB
#undef PG8_MMA
#undef PG8_WAIT_V
#undef PG8_WAIT_L
#undef PG8_BAR
#undef PG8_SCHED
}
}
namespace attn {
using bf16 = __hip_bfloat16;
constexpr int   D = 128, NW = 8, QBLK = 32, KVBLK = 64;
constexpr float SCALE = 0.088388347648318440f;
constexpr float THR = 8.f;
constexpr int SDEPTH = 2;
constexpr int LDQ = 1536, LDK = 128, LDO = 2048;
constexpr size_t SHM_V = KVBLK * D * 2, SHM_K = KVBLK * D * 2, SHM_ATTN = 2 * SHM_V + 2 * SHM_K + NW * 64 * 4;
using bf16x8 = __attribute__((ext_vector_type(8))) short;
using s16x4  = __attribute__((ext_vector_type(4))) short;
using f32x16 = __attribute__((ext_vector_type(16))) float;
using f32x8  = __attribute__((ext_vector_type(8))) float;
using f32x4v = __attribute__((ext_vector_type(4))) float;
using u32x4  = __attribute__((ext_vector_type(4))) unsigned;
#define KSWZ(row, colB) ((row) * 256 + ((colB) ^ (((row) & 7) << 4)))
#define SBAR() __builtin_amdgcn_sched_barrier(0)
__device__ __forceinline__ int crow(int r, int hi) { return (r & 3) + 8 * (r >> 2) + 4 * hi; }
__device__ __forceinline__ unsigned cvtpk(float lo, float hi) {
  unsigned r; asm volatile("v_cvt_pk_bf16_f32 %0, %1, %2" : "=v"(r) : "v"(lo), "v"(hi)); return r;
}
template <typename TIn> struct Stage;
template <> struct Stage<bf16>  { using T = bf16x8;
  __device__ static __forceinline__ T ld8(const bf16* p) { return *reinterpret_cast<const bf16x8*>(p); }
  __device__ static __forceinline__ bf16x8 tobf(T x) { return x; } };
template <> struct Stage<float> { using T = f32x8;
  __device__ static __forceinline__ T ld8(const float* p) { return *reinterpret_cast<const f32x8*>(p); }
  __device__ static __forceinline__ bf16x8 tobf(T x) {
    u32x4 w = {cvtpk(x[0], x[1]), cvtpk(x[2], x[3]), cvtpk(x[4], x[5]), cvtpk(x[6], x[7])}; return *reinterpret_cast<bf16x8*>(&w); } };

__device__ __forceinline__ void partialSM(f32x16& p0, f32x16& p1, float& m_reg, float& mn, float& alpha) {
  constexpr float C = SCALE * 1.4426950408889634f;
  float pmax = p0[0]; for (int r = 1; r < 16; ++r) pmax = fmaxf(pmax, p0[r]); for (int r = 0; r < 16; ++r) pmax = fmaxf(pmax, p1[r]);
  { auto rr = __builtin_amdgcn_permlane32_swap(__float_as_uint(pmax), __float_as_uint(pmax), false, false);
    pmax = fmaxf(__uint_as_float(rr[0]), __uint_as_float(rr[1])); }
  if (__builtin_expect(__all(pmax - m_reg <= THR / SCALE), 1)) { mn = m_reg; alpha = 1.f; }
  else { mn = fmaxf(m_reg, pmax); alpha = __builtin_amdgcn_exp2f((m_reg - mn) * C); m_reg = mn; }
  float mnC = -mn * C;
  for (int r = 0; r < 16; ++r) p0[r] = fmaf(p0[r], C, mnC); for (int r = 0; r < 16; ++r) p1[r] = fmaf(p1[r], C, mnC);
  for (int r = 0; r < 16; ++r) p0[r] = __builtin_amdgcn_exp2f(p0[r]);
}
__device__ __forceinline__ void finishSM(f32x16& p0, f32x16& p1, float alpha, float& l_reg, bf16x8& pa0, bf16x8& pa1, bf16x8& pa2, bf16x8& pa3) {
  for (int r = 0; r < 16; ++r) p1[r] = __builtin_amdgcn_exp2f(p1[r]);
  float ps = 0; for (int r = 0; r < 16; ++r) ps += p0[r]; for (int r = 0; r < 16; ++r) ps += p1[r];
  { auto rr = __builtin_amdgcn_permlane32_swap(__float_as_uint(ps), __float_as_uint(ps), false, false);
    ps = __uint_as_float(rr[0]) + __uint_as_float(rr[1]); }
  l_reg = l_reg * alpha + ps;
#define PK4(P, BASE, OUT) do { unsigned a0 = cvtpk(P[BASE + 0], P[BASE + 1]), a1 = cvtpk(P[BASE + 2], P[BASE + 3]);   \
    unsigned b0 = cvtpk(P[BASE + 4], P[BASE + 5]), b1 = cvtpk(P[BASE + 6], P[BASE + 7]);                              \
    auto r0 = __builtin_amdgcn_permlane32_swap(a0, b0, false, false); auto r1 = __builtin_amdgcn_permlane32_swap(a1, b1, false, false); \
    u32x4 w = {r0[0], r1[0], r0[1], r1[1]}; OUT = *reinterpret_cast<bf16x8*>(&w); } while (0)
  PK4(p0, 0, pa0); PK4(p0, 8, pa1); PK4(p1, 0, pa2); PK4(p1, 8, pa3);
#undef PK4
}
__device__ __forceinline__ void qkt(f32x16& p0, f32x16& p1, const bf16* Ks, const bf16x8* qr, int r32, int hi) {
  p0 = f32x16{}; p1 = f32x16{};
  for (int d0 = 0; d0 < 8; ++d0) { int cb = (d0 * 16 + hi * 8) * 2;
    bf16x8 b0 = *reinterpret_cast<const bf16x8*>((const char*)Ks + KSWZ(r32, cb));
    bf16x8 b1 = *reinterpret_cast<const bf16x8*>((const char*)Ks + KSWZ(32 + r32, cb));
    p0 = __builtin_amdgcn_mfma_f32_32x32x16_bf16(b0, qr[d0], p0, 0, 0, 0);
    p1 = __builtin_amdgcn_mfma_f32_32x32x16_bf16(b1, qr[d0], p1, 0, 0, 0); }
}
__device__ __forceinline__ int v_st(int k, int c) { const int kk = (k & ~0xC) | ((k & 4) << 1) | ((k & 8) >> 1); return ((kk >> 3) * 4 + (c >> 5)) * 512 + ((kk & 7) * 32 + (c & 31)) * 2; }
__device__ __forceinline__ int v_rd_base(int lane) { return ((lane & 3) << 3) | (((lane >> 2) & 3) << 6) | (((lane >> 4) & 1) << 5) | (((lane >> 5) & 1) << 8); }
constexpr int v_rd_off(int d0, int ks, int half) { return d0 * 512 + ks * 4096 + half * 2048; }
template <int OFF> __device__ __forceinline__ s16x4 tr_read(int vb) {
  s16x4 r; asm volatile("ds_read_b64_tr_b16 %0, %1 offset:%2" : "=&v"(r) : "v"(vb), "i"(OFF) : "memory"); return r;
}
template <int D0> __device__ __forceinline__ void pv_one(f32x16& od, int vb, bf16x8 pa0, bf16x8 pa1, bf16x8 pa2, bf16x8 pa3) {
  const s16x4 l0 = tr_read<v_rd_off(D0, 0, 0)>(vb), h0 = tr_read<v_rd_off(D0, 0, 1)>(vb), l1 = tr_read<v_rd_off(D0, 1, 0)>(vb), h1 = tr_read<v_rd_off(D0, 1, 1)>(vb);
  const s16x4 l2 = tr_read<v_rd_off(D0, 2, 0)>(vb), h2 = tr_read<v_rd_off(D0, 2, 1)>(vb), l3 = tr_read<v_rd_off(D0, 3, 0)>(vb), h3 = tr_read<v_rd_off(D0, 3, 1)>(vb);
  asm volatile("s_waitcnt lgkmcnt(0)" ::: "memory"); SBAR();
#define PK(L, H) (bf16x8){L[0], L[1], L[2], L[3], H[0], H[1], H[2], H[3]}
  od = __builtin_amdgcn_mfma_f32_32x32x16_bf16(pa0, PK(l0, h0), od, 0, 0, 0);
  od = __builtin_amdgcn_mfma_f32_32x32x16_bf16(pa1, PK(l1, h1), od, 0, 0, 0);
  od = __builtin_amdgcn_mfma_f32_32x32x16_bf16(pa2, PK(l2, h2), od, 0, 0, 0);
  od = __builtin_amdgcn_mfma_f32_32x32x16_bf16(pa3, PK(l3, h3), od, 0, 0, 0);
#undef PK
}
__device__ __forceinline__ void pv_d0(f32x16* o, int vb, bf16x8 pa0, bf16x8 pa1, bf16x8 pa2, bf16x8 pa3) {
  pv_one<0>(o[0], vb, pa0, pa1, pa2, pa3); pv_one<1>(o[1], vb, pa0, pa1, pa2, pa3); pv_one<2>(o[2], vb, pa0, pa1, pa2, pa3); pv_one<3>(o[3], vb, pa0, pa1, pa2, pa3);
}

template <typename TQ>
__device__ __forceinline__ void attn_dense_body(const TQ* __restrict__ Qb, const bf16* __restrict__ Kh, const bf16* __restrict__ Vh,
                                                unsigned short* __restrict__ Ob, int seq, char* lds, const float* __restrict__ qgain, const float* __restrict__ rope_blk) {
  using St = Stage<bf16>; using SQ = Stage<TQ>;
  int tid_o = threadIdx.x; asm volatile("" : "+v"(tid_o));
  const int tid = tid_o, wid = tid >> 6, lane = tid & 63, r32 = lane & 31, hi = lane >> 5;
  bf16* V_lds = (bf16*)lds; bf16* K_lds = (bf16*)(lds + 2 * SHM_V);
  float* ws = (float*)(lds + 2 * SHM_V + 2 * SHM_K) + wid * 64; float* li_l = ws; float* al_l = ws + 32;
  float m_reg = -1e30f, l_reg = 0; f32x16 o[4] = {}; bf16x8 qr[8];
  const TQ* Qw = Qb + (long)(wid * QBLK + r32) * LDQ + hi * 8;
  {
    float x[8][8]; float ss = 0.f;
#pragma unroll
    for (int d0 = 0; d0 < 8; ++d0) { const u32x4 raw = *reinterpret_cast<const u32x4*>(Qw + d0 * 16);
#pragma unroll
      for (int q = 0; q < 4; ++q) { x[d0][2 * q] = __uint_as_float(raw[q] << 16); x[d0][2 * q + 1] = __uint_as_float(raw[q] & 0xffff0000u); } }
#pragma unroll
    for (int d0 = 0; d0 < 8; ++d0)
#pragma unroll
      for (int e = 0; e < 8; ++e) ss += x[d0][e] * x[d0][e];
    ss += __shfl_xor(ss, 32);
    const float rs = 1.f / sqrtf(ss * (1.f / 128.f) + 1e-6f);
#pragma unroll
    for (int d0 = 0; d0 < 8; ++d0) { const float* gp = qgain + 16 * d0 + 8 * hi; const f32x8 g = *reinterpret_cast<const f32x8*>(gp);
#pragma unroll
      for (int e = 0; e < 8; ++e) x[d0][e] *= rs * g[e]; }
    if (rope_blk) {
      const float* rp = rope_blk + (long)(wid * QBLK + r32) * 128;
#pragma unroll
      for (int a = 0; a < 2; ++a)
#pragma unroll
        for (int dd = 0; dd < 2; ++dd) { const float* cp = rp + 2 * (a * 32 + 16 * dd + 8 * hi);
#pragma unroll
          for (int e4 = 0; e4 < 4; ++e4) { const f32x4v cs = *reinterpret_cast<const f32x4v*>(cp + 4 * e4);
#pragma unroll
            for (int u = 0; u < 2; ++u) { const int e = 2 * e4 + u; const float c = cs[2 * u], sn = cs[2 * u + 1], x1 = x[4 * a + dd][e], x2 = x[4 * a + 2 + dd][e];
              x[4 * a + dd][e] = x1 * c - x2 * sn; x[4 * a + 2 + dd][e] = x1 * sn + x2 * c; } } }
    }
#pragma unroll
    for (int d0 = 0; d0 < 8; ++d0) { u32x4 w = {cvtpk(x[d0][0], x[d0][1]), cvtpk(x[d0][2], x[d0][3]), cvtpk(x[d0][4], x[d0][5]), cvtpk(x[d0][6], x[d0][7])}; qr[d0] = *reinterpret_cast<bf16x8*>(&w); }
  }
  const int sr = tid >> 4, sc = (tid & 15) * 8, vst0 = v_st(sr, sc), vst1 = v_st(32 + sr, sc);
  const int vb0 = (int)(uintptr_t)V_lds + v_rd_base(lane);
  struct { typename St::T vs0, vs1, ks0, ks1; } sr_[SDEPTH];
#define SLOAD(i, k0) do { sr_[i].vs0 = St::ld8(&Vh[(long)((k0) + sr) * LDK + sc]); sr_[i].vs1 = St::ld8(&Vh[(long)((k0) + 32 + sr) * LDK + sc]); \
    sr_[i].ks0 = St::ld8(&Kh[(long)((k0) + sr) * LDK + sc]); sr_[i].ks1 = St::ld8(&Kh[(long)((k0) + 32 + sr) * LDK + sc]); } while (0)
#define SWRITE(b, i) do { *(bf16x8*)((char*)V_lds + (b) * SHM_V + vst0) = St::tobf(sr_[i].vs0);          \
    *(bf16x8*)((char*)V_lds + (b) * SHM_V + vst1) = St::tobf(sr_[i].vs1); int kc = sc * 2;               \
    *(bf16x8*)((char*)K_lds + (b) * SHM_K + KSWZ(sr, kc)) = St::tobf(sr_[i].ks0);                       \
    *(bf16x8*)((char*)K_lds + (b) * SHM_K + KSWZ(32 + sr, kc)) = St::tobf(sr_[i].ks1); } while (0)
#define SWAIT() do { if constexpr (SDEPTH == 2) asm volatile("s_waitcnt vmcnt(4)" ::: "memory"); else asm volatile("s_waitcnt vmcnt(0)" ::: "memory"); } while (0)
#define RESC(a) do { if (__any((a) < 1.f)) { if (hi == 0) al_l[r32] = (a); asm volatile("s_waitcnt lgkmcnt(0)" ::: "memory"); \
    for (int d = 0; d < 4; ++d) for (int r = 0; r < 16; ++r) o[d][r] *= al_l[crow(r, hi)]; } } while (0)
  f32x16 pA0, pA1, pB0, pB1; float mnA, mnB, alA, alB; bf16x8 pa0, pa1, pa2, pa3; const int NT = seq / KVBLK;
  constexpr int SE = 0, SO = SDEPTH - 1;
  SLOAD(SE, 0); asm volatile("s_waitcnt vmcnt(0)" ::: "memory"); SWRITE(0, SE); __syncthreads();
  qkt(pA0, pA1, K_lds, qr, r32, hi); partialSM(pA0, pA1, m_reg, mnA, alA);
  SLOAD(SO, KVBLK); if constexpr (SDEPTH == 2) { if (2 < NT) SLOAD(SE, 2 * KVBLK); }
  SWAIT(); SWRITE(1, SO); __syncthreads();
  for (int j = 1; j + 1 < NT; j += 2) {
    SBAR(); qkt(pB0, pB1, (bf16*)((char*)K_lds + SHM_K), qr, r32, hi);
    finishSM(pA0, pA1, alA, l_reg, pa0, pa1, pa2, pa3); SBAR();
    SLOAD(SO, (j + SDEPTH) * KVBLK); SBAR();
    pv_d0(o, vb0, pa0, pa1, pa2, pa3); partialSM(pB0, pB1, m_reg, mnB, alB);
    __syncthreads(); SWAIT(); SWRITE(0, SE);
    RESC(alB); __syncthreads();
    SBAR(); qkt(pA0, pA1, K_lds, qr, r32, hi);
    finishSM(pB0, pB1, alB, l_reg, pa0, pa1, pa2, pa3); SBAR();
    if (SDEPTH == 1 || j + 3 < NT) SLOAD(SE, (j + 1 + SDEPTH) * KVBLK); SBAR();
    pv_d0(o, vb0 + (int)SHM_V, pa0, pa1, pa2, pa3); partialSM(pA0, pA1, m_reg, mnA, alA);
    __syncthreads(); SWAIT(); SWRITE(1, SO);
    RESC(alA); __syncthreads();
  }
  SBAR(); qkt(pB0, pB1, (bf16*)((char*)K_lds + SHM_K), qr, r32, hi);
  finishSM(pA0, pA1, alA, l_reg, pa0, pa1, pa2, pa3); SBAR();
  pv_d0(o, vb0, pa0, pa1, pa2, pa3); partialSM(pB0, pB1, m_reg, mnB, alB);
  __syncthreads(); RESC(alB);
  finishSM(pB0, pB1, alB, l_reg, pa0, pa1, pa2, pa3); SBAR();
  pv_d0(o, vb0 + (int)SHM_V, pa0, pa1, pa2, pa3);
  if (hi == 0) li_l[r32] = l_reg; asm volatile("s_waitcnt lgkmcnt(0)" ::: "memory");
  float rli[16];
#pragma unroll
  for (int r = 0; r < 16; ++r) rli[r] = __builtin_amdgcn_rcpf(li_l[crow(r, hi)]);
  unsigned short* Ow = Ob + (long)(wid * QBLK) * LDO;
  __syncthreads();
  unsigned short* stg = (unsigned short*)(lds + wid * 8192);
#pragma unroll
  for (int r = 0; r < 16; ++r) { const int orow = crow(r, hi);
#pragma unroll
    for (int d0 = 0; d0 < 4; ++d0) stg[orow * 128 + d0 * 32 + r32] = (unsigned short)cvtpk(o[d0][r] * rli[r], 0.f); }
  asm volatile("s_waitcnt lgkmcnt(0)" ::: "memory");
#pragma unroll
  for (int i = 0; i < 8; ++i) { const int q = lane + 64 * i, row = q >> 4, c16 = q & 15;
    *reinterpret_cast<u32x4*>(Ow + (long)row * LDO + c16 * 8) = *reinterpret_cast<const u32x4*>(stg + row * 128 + c16 * 8); }
#undef SLOAD
#undef SWRITE
#undef SWAIT
#undef RESC
}

}
#define GAS __attribute__((address_space(1)))
#define LAS __attribute__((address_space(3)))
typedef unsigned short bf16;
typedef unsigned v4u __attribute__((ext_vector_type(4)));
typedef unsigned v2u __attribute__((ext_vector_type(2)));
typedef float f32x4 __attribute__((ext_vector_type(4)));
typedef float f32x2 __attribute__((ext_vector_type(2)));
typedef float f32x16 __attribute__((ext_vector_type(16)));
typedef short bf16x8 __attribute__((ext_vector_type(8)));
typedef short s16x4 __attribute__((ext_vector_type(4)));
typedef GAS unsigned gu32;
#define RLX_AGENT __ATOMIC_RELAXED, __HIP_MEMORY_SCOPE_AGENT
#define LDS_WAIT() asm volatile("s_waitcnt lgkmcnt(0)" ::: "memory")
#define VM_WAIT() asm volatile("s_waitcnt vmcnt(0)" ::: "memory")

constexpr int DM = 2048, NBATCH = 2, SEQ = 8192, CTXL = 256, SB = SEQ + CTXL, MALL = NBATCH * SB, FFD = 5632, PPB = 33;
constexpr int NWAVES = 8, NPH = 26;
constexpr float EPS = 1e-6f, LOG2E = 1.4426950408889634f;
static_assert(SB == pg8::SB_ && PPB == pg8::PPB, "row order constants");
constexpr size_t MiB = 1u << 20;
constexpr size_t WS_CTL = 0, CTL_ZERO_BYTES = 1 * MiB;
constexpr size_t WS_MOD = 1 * MiB;
constexpr size_t WS_ROPE = 2 * MiB;
constexpr size_t WS_DFT256 = 6 * MiB;
constexpr size_t WS_WFIN = 8 * MiB;
constexpr size_t WS_WFOUT = 184 * MiB;
constexpr size_t WS_WABIN = 272 * MiB;
constexpr size_t WS_WABOUT = 286 * MiB;
constexpr size_t WS_WHGIN = 296 * MiB;
constexpr size_t WS_WHGOUT = 336 * MiB;
constexpr size_t WS_H = 344 * MiB;
constexpr size_t WS_XN = 476 * MiB;
constexpr size_t WS_HID = 542 * MiB;
constexpr size_t WS_USEG = WS_HID, WS_DSEG = WS_HID + 134 * MiB;
constexpr size_t WS_OV = 724 * MiB;
constexpr size_t WS_DFT = WS_OV, WS_DFTA = WS_OV + 64 * MiB, WS_UWL = WS_OV + 256 * MiB, WS_UWC = WS_OV + 288 * MiB, WS_QB = WS_OV + 289 * MiB, WS_KB = WS_OV + 339 * MiB, WS_VB = WS_OV + 356 * MiB, WS_MIX = WS_OV + 373 * MiB;
constexpr size_t WS_HG = WS_OV, WS_OFW = WS_OV + 330 * MiB, WS_OBW = WS_OV + 396 * MiB;
constexpr size_t WS_SLAB = WS_OV + 462 * MiB;
constexpr size_t WS_DLT = WS_SLAB + 44 * MiB;
constexpr size_t WS_END = WS_DLT + 66 * MiB;
static_assert(WS_MIX + (size_t)MALL * 2048 * 2 <= WS_END && WS_OBW + (size_t)MALL * 2048 * 2 <= WS_END && WS_HID + (size_t)MALL * FFD * 2 <= WS_OV && WS_DSEG + 2112 * 128 * 4 <= WS_OV, "ws map");
static_assert(WS_WFIN + 4ull * 11264 * 2048 * 2 <= WS_WFOUT && WS_WFOUT + 4ull * 2048 * 5632 * 2 <= WS_WABIN && WS_H + (size_t)MALL * 2048 * 4 <= WS_XN && WS_XN + (size_t)MALL * 2048 * 2 <= WS_HID, "ws map 2");
constexpr int CW_BAR = 4096;
constexpr int CW_QHEAD = 64;
constexpr int LDS_BYTES = 163840, MISC_OFF = LDS_BYTES - 256;
static_assert(pg8::STAGE_BYTES <= MISC_OFF, "LDS map");

__device__ __forceinline__ unsigned f2bf(float f) { unsigned u = __builtin_bit_cast(unsigned, f); return (u + 0x7fffu + ((u >> 16) & 1u)) >> 16; }
__device__ __forceinline__ unsigned pk2(float lo, float hi) { return pg8::cvt_pk_bf16(lo, hi); }
__device__ __forceinline__ float bf2f(unsigned x) { return __builtin_bit_cast(float, x << 16); }
__device__ __forceinline__ float exp_f(float x) { return __builtin_amdgcn_exp2f(x * LOG2E); }
__device__ __forceinline__ float wave_sum(float v) {
#pragma unroll
    for (int o = 1; o < 64; o <<= 1) v += __shfl_xor(v, o);
    return v;
}
#define XB_TMO      128
#define XB_XCNT(j)  (256  + 64 * (j))
#define XB_XSUB(j)  (1280 + 64 * (j))
#define XB_XGEN(j)  (2304 + 64 * (j))
#define XB_TOP      3328
#define XB_TOPGEN   3392
#define XCD_BAR_WORDS 3456
#define XB_SPIN_CAP (1u << 18)

__device__ __forceinline__ unsigned xb_ld(unsigned* p)              { return __hip_atomic_load(p, __ATOMIC_RELAXED, __HIP_MEMORY_SCOPE_AGENT); }
__device__ __forceinline__ unsigned xb_add(unsigned* p, unsigned v) { return __hip_atomic_fetch_add(p, v, __ATOMIC_RELAXED, __HIP_MEMORY_SCOPE_AGENT); }
__device__ __forceinline__ unsigned xb_xcc_id() { return (unsigned)__builtin_amdgcn_s_getreg((3 << 11) | 20) & 0xFu; }
#define XB_SPIN(cond, bar) do { unsigned _sp = 0; while (cond) { __builtin_amdgcn_s_sleep(1); \
    if ((++_sp & 255u) == 0u) { if (xb_ld(&(bar)[XB_TMO])) break; if (_sp > XB_SPIN_CAP) { atomicAdd(&(bar)[XB_TMO], 1u); break; } } } } while (0)

struct XcdBarrier {
    unsigned* bar; unsigned x;
    volatile LAS unsigned* st;
};

__device__ __forceinline__ XcdBarrier xcd_barrier_post(unsigned* bar, volatile LAS unsigned* st) {
    XcdBarrier b; b.bar = bar; b.x = xb_xcc_id(); b.st = st;
    if (threadIdx.x == 0) (void)xb_add(&bar[XB_XCNT(b.x)], 1u);
    return b;
}
__device__ __forceinline__ void xcd_barrier_complete(unsigned* bar, unsigned x, unsigned& nloc, unsigned& nx) {
    const unsigned G = gridDim.x * gridDim.y * gridDim.z;
    unsigned sum, cnt, mine, sp = 0u;
    for (;;) {
        sum = 0u; cnt = 0u; mine = 0u;
#pragma unroll
        for (unsigned j = 0; j < 16; ++j) { const unsigned c = xb_ld(&bar[XB_XCNT(j)]); sum += c; cnt += (c > 0u) ? 1u : 0u; mine = (j == x) ? c : mine; }
        if (sum == G) break;
        __builtin_amdgcn_s_sleep(1);
        if ((++sp & 255u) == 0u) { if (xb_ld(&bar[XB_TMO])) break; if (sp > XB_SPIN_CAP) { atomicAdd(&bar[XB_TMO], 1u); break; } }
    }
    nloc = mine > 0u ? mine : 1u; nx = cnt > 0u ? cnt : 1u;
}

__device__ __forceinline__ void xcd_barrier(const XcdBarrier& b) {
    asm volatile("s_waitcnt vmcnt(0)" ::: "memory");
    __syncthreads();
    if (threadIdx.x == 0) {
        unsigned* bar = b.bar;
        __builtin_amdgcn_s_waitcnt(0);
        unsigned nloc = b.st[0], nx = b.st[1];
        if (nloc == 0u) { xcd_barrier_complete(bar, b.x, nloc, nx); b.st[0] = nloc; b.st[1] = nx; }
        const unsigned old = xb_add(&bar[XB_XSUB(b.x)], 1u);
        const unsigned gen = old / nloc;
        if (old + 1u == (gen + 1u) * nloc) {
            __builtin_amdgcn_fence(__ATOMIC_RELEASE, "agent");
            asm volatile("s_waitcnt vmcnt(0)" ::: "memory");
            const unsigned og = xb_add(&bar[XB_TOP], 1u);
            const unsigned tg = og / nx;
            if (og + 1u == (tg + 1u) * nx) xb_add(&bar[XB_TOPGEN], 1u);
            else XB_SPIN(xb_ld(&bar[XB_TOPGEN]) == tg, bar);
            __builtin_amdgcn_fence(__ATOMIC_ACQUIRE, "agent");
            xb_add(&bar[XB_XGEN(b.x)], 1u);
            asm volatile("s_waitcnt vmcnt(0)" ::: "memory");
        } else {
            XB_SPIN(xb_ld(&bar[XB_XGEN(b.x)]) == gen, bar);
            __builtin_amdgcn_fence(__ATOMIC_ACQUIRE, "agent");
            asm volatile("s_waitcnt vmcnt(0)" ::: "memory");
        }
    }
    __syncthreads();
}

struct TrItem { const float* W; bf16* WT; int ldw, ldt, k0, n0, drow0; float sc; };
__device__ __forceinline__ TrItem tr_decode(int r, const float* const* in, unsigned char* ws) {
    constexpr int I_A = 4 * 32 * 352, I_B = 4 * 88 * 64, I_C = 32 * 80, I_D = 32 * 64, I_E = 32 * 320;
    TrItem t; t.sc = 1.f;
    if (r < I_A) { const int mtx = r / (32 * 352), q = r % (32 * 352), kb = q / 352, nb = q % 352, n0 = 32 * nb, half = n0 >= FFD ? 1 : 0, np = n0 - half * FFD;
        t.W = in[7] + (size_t)mtx * 2048 * 11264; t.WT = (bf16*)(ws + WS_WFIN) + (size_t)mtx * 11264 * 2048; t.ldw = 11264; t.ldt = 2048; t.k0 = 64 * kb; t.n0 = n0; t.drow0 = (np >> 7) * 256 + half * 128 + (np & 127); t.sc = half ? 0.6931471805599453f : 1.4426950408889634f; return t; } r -= I_A;
    if (r < I_B) { const int mtx = r / (88 * 64), q = r % (88 * 64), kb = q / 64, nb = q % 64;
        t.W = in[8] + (size_t)mtx * FFD * 2048; t.WT = (bf16*)(ws + WS_WFOUT) + (size_t)mtx * 2048 * FFD; t.ldw = 2048; t.ldt = FFD; t.k0 = 64 * kb; t.n0 = 32 * nb; t.drow0 = 32 * nb; return t; } r -= I_B;
    if (r < I_C) { const int kb = r / 80, nb = r % 80; t.W = in[9]; t.WT = (bf16*)(ws + WS_WABIN); t.ldw = 3072; t.ldt = 2048; t.k0 = 64 * kb; t.n0 = 512 + 32 * nb; t.drow0 = 1024 + 32 * nb; return t; } r -= I_C;
    if (r < I_D) { const int kb = r / 64, nb = r % 64; t.W = in[11]; t.WT = (bf16*)(ws + WS_WABOUT); t.ldw = 2048; t.ldt = 2048; t.k0 = 64 * kb; t.n0 = 32 * nb; t.drow0 = 32 * nb; return t; } r -= I_D;
    if (r < I_E) { const int kb = r / 320, nb = r % 320; t.W = in[12]; t.WT = (bf16*)(ws + WS_WHGIN); t.ldw = 10240; t.ldt = 2048; t.k0 = 64 * kb; t.n0 = 32 * nb; t.drow0 = 32 * nb; return t; } r -= I_E;
    { const int kb = r / 64, nb = r % 64; t.W = in[15]; t.WT = (bf16*)(ws + WS_WHGOUT); t.ldw = 2048; t.ldt = 2048; t.k0 = 64 * kb; t.n0 = 32 * nb; t.drow0 = 32 * nb; return t; }
}
constexpr int TR_NITEMS = 4 * 32 * 352 + 4 * 88 * 64 + 32 * 80 + 32 * 64 + 32 * 320 + 32 * 64;
constexpr int TR_EARLY = TR_NITEMS;
__device__ __forceinline__ int tr_early_id(int e) { return e; }
__device__ __forceinline__ void tr_load(const TrItem& t, float (&v)[32], int lane) {
    const float* p = t.W + (size_t)(t.k0 + 32 * (lane >> 5)) * t.ldw + t.n0 + (lane & 31);
#pragma unroll
    for (int i = 0; i < 32; ++i) v[i] = p[(size_t)i * t.ldw];
}
__device__ __forceinline__ void tr_store(const TrItem& t, const float (&v)[32], LAS float* scr_f, int lane) {
    LAS unsigned* scr = (LAS unsigned*)scr_f;
    const int n = lane & 31, h = lane >> 5;
#pragma unroll
    for (int q = 0; q < 16; ++q) scr[n * 33 + 16 * h + q] = pk2(v[2 * q] * t.sc, v[2 * q + 1] * t.sc);
    LDS_WAIT(); asm volatile("" ::: "memory");
    const int c = lane & 7;
#pragma unroll
    for (int j = 0; j < 4; ++j) { const int nr = (lane >> 3) + 8 * j; const LAS unsigned* sp = scr + nr * 33 + 4 * c;
        v4u o; o.x = sp[0]; o.y = sp[1]; o.z = sp[2]; o.w = sp[3];
        *(GAS v4u*)(t.WT + (size_t)(t.drow0 + nr) * t.ldt + t.k0 + 8 * c) = o; }
    LDS_WAIT(); asm volatile("" ::: "memory");
}
struct Args { const float* in[17]; float* out; unsigned char* ws; int ph_lo, ph_hi; };

#ifndef PROBE_PRO
#define PROBE_PRO 31
#endif
__device__ __forceinline__ void prologue_phase(const Args& P, LAS unsigned char* lds, int vcu, int G, int rep) {
    int tid_o = threadIdx.x; asm volatile("" : "+v"(tid_o));
    const int tid = tid_o, lane = tid & 63, wave = __builtin_amdgcn_readfirstlane(tid >> 6);
    const int gw = vcu * NWAVES + wave, NGW = G * NWAVES;
    unsigned char* ws = P.ws;
    if (!rep || (PROBE_PRO & 1)) {
        LAS float* scr = (LAS float*)(lds + wave * 16384);
        float va[32], vb[32];
        int it = gw;
        if (it < TR_EARLY) { const TrItem t0 = tr_decode(tr_early_id(it), P.in, ws); tr_load(t0, va, lane); }
        for (; it < TR_EARLY; it += 2 * NGW) {
            const TrItem ta = tr_decode(tr_early_id(it), P.in, ws);
            const bool hb = it + NGW < TR_EARLY; TrItem tb = ta;
            if (hb) { tb = tr_decode(tr_early_id(it + NGW), P.in, ws); tr_load(tb, vb, lane); }
            tr_store(ta, va, scr, lane);
            if (it + 2 * NGW < TR_EARLY) { const TrItem tc = tr_decode(tr_early_id(it + 2 * NGW), P.in, ws); tr_load(tc, va, lane); }
            if (hb) tr_store(tb, vb, scr, lane);
        }
    }
    __syncthreads();
    if (!rep || (PROBE_PRO & 2)) {
        f32x2* rope = (f32x2*)(ws + WS_ROPE);
        for (int e = vcu * 512 + tid; e < 8192 * 64; e += G * 512) { const int t = e >> 6, i = e & 63, fi = i & 31, pos = (i >> 5) ? (t & 63) : (t >> 6);
            const float inv = powf(10000.f, -(float)(2 * fi) / 64.f), ang = (float)pos * inv; f32x2 cs; cs.x = cosf(ang); cs.y = sinf(ang); rope[e] = cs; }
    }
    if (!rep || (PROBE_PRO & 4)) {
        LAS bf16* tab = (LAS bf16*)lds;
        for (int j = tid; j < 8192; j += 512) tab[j] = (bf16)f2bf(cospif((float)j * (1.f / 4096.f)));
        __syncthreads();
        bf16* dfta = (bf16*)(ws + WS_DFTA);
        for (int k = vcu; k < 1024; k += G) if (tid < 256) { const int tp0 = tid * 8, part = tp0 >> 10, t0 = tp0 & 1023; unsigned v[8];
#pragma unroll
            for (int e = 0; e < 8; ++e) { const unsigned j = ((unsigned)k * (unsigned)(t0 + e)) & 1023u; const unsigned idx = part ? ((8u * j + 6144u) & 8191u) : 8u * j; v[e] = tab[idx]; }
            v4u o; o.x = v[0] | (v[1] << 16); o.y = v[2] | (v[3] << 16); o.z = v[4] | (v[5] << 16); o.w = v[6] | (v[7] << 16);
            *(GAS v4u*)(dfta + (size_t)k * 2048 + tp0) = o; }
        __syncthreads();
    }
    if (!rep || (PROBE_PRO & 8)) {
        LAS float* Wl = (LAS float*)lds;
        LAS float* tb = (LAS float*)(lds + 32768);
        if (tid < 128) tb[tid] = cospif((float)tid * (1.f / 64.f)) * 0.08838834764831845f;
        bf16* wt = (bf16*)(ws + WS_WABIN);
        for (int it = vcu; it < 256; it += G) { const int kb = it >> 2, g = it & 3;
            __syncthreads();
            for (int e = tid; e < 32 * 32; e += 512) { const int kk = e >> 5, c4 = e & 31; *(LAS f32x4*)(Wl + kk * 128 + 4 * c4) = *(const f32x4*)(P.in[9] + (size_t)(32 * kb + kk) * 3072 + g * 128 + 4 * c4); }
            __syncthreads();
            const int np = tid & 255, part = np >> 7, c2 = np & 127, kh = tid >> 8;
            float acc[16];
#pragma unroll
            for (int i = 0; i < 16; ++i) acc[i] = 0.f;
            for (int c = 0; c < 128; c += 4) { float t[4];
#pragma unroll
                for (int e = 0; e < 4; ++e) { int j = ((c + e) * c2) & 127; if (part) j = (j - 32) & 127; t[e] = tb[j]; }
#pragma unroll
                for (int i = 0; i < 16; ++i) { const f32x4 w4 = *(const LAS f32x4*)(Wl + (kh * 16 + i) * 128 + c); acc[i] += (w4.x * t[0] + w4.y * t[1]) + (w4.z * t[2] + w4.w * t[3]); } }
            bf16* dst = wt + (size_t)(part * 512 + g * 128 + c2) * 2048 + 32 * kb + kh * 16;
#pragma unroll
            for (int q = 0; q < 2; ++q) { v4u o; o.x = pk2(acc[8 * q], acc[8 * q + 1]); o.y = pk2(acc[8 * q + 2], acc[8 * q + 3]); o.z = pk2(acc[8 * q + 4], acc[8 * q + 5]); o.w = pk2(acc[8 * q + 6], acc[8 * q + 7]);
                *(GAS v4u*)(dst + 8 * q) = o; }
        }
        __syncthreads();
    }
    if (!rep || (PROBE_PRO & 16)) {
        LAS float* Sv = (LAS float*)lds;
        LAS float* red = (LAS float*)(lds + 32768);
        for (int e = tid; e < 3 * 2048; e += 512) { const int rr = e >> 11, k = e & 2047; const float v = rr < 2 ? P.in[1][rr * 2048 + k] : P.in[3][k]; Sv[e] = v / (1.f + expf(-v)); }
        __syncthreads();
        float* mod = (float*)(ws + WS_MOD);
        const int cl = tid & 15, kg = tid >> 4;
        for (int u = vcu; u < 576; u += G) { const int layer = u / 288, cb = u % 288;
            const float* wp = P.in[4] + (size_t)layer * 2048 * 18432 + (size_t)64 * cb + 4 * cl;
            f32x4 a0 = {0.f, 0.f, 0.f, 0.f}, a1 = a0, a2 = a0;
            for (int i0 = 0; i0 < 64; i0 += 8) { f32x4 w[8];
#pragma unroll
                for (int i = 0; i < 8; ++i) w[i] = *(const f32x4*)(wp + (size_t)(kg + 32 * (i0 + i)) * 18432);
#pragma unroll
                for (int i = 0; i < 8; ++i) { const int k = kg + 32 * (i0 + i); a0 += w[i] * Sv[k]; a1 += w[i] * Sv[2048 + k]; a2 += w[i] * Sv[4096 + k]; } }
            __syncthreads();
            LAS float* rp = red + (kg * 16 + cl) * 12;
            *(LAS f32x4*)(rp) = a0; *(LAS f32x4*)(rp + 4) = a1; *(LAS f32x4*)(rp + 8) = a2;
            __syncthreads();
            if (tid < 192) { const int c16 = tid / 12, q = tid % 12, rr = q >> 2, e = q & 3; float s = 0.f;
                for (int g2 = 0; g2 < 32; ++g2) s += red[(g2 * 16 + c16) * 12 + q];
                const int col = 64 * cb + 4 * c16 + e; mod[(size_t)(layer * 3 + rr) * 18432 + col] = s + P.in[5][layer * 18432 + col]; }
        }
        __syncthreads();
    }
}

__device__ __forceinline__ void norm_phase(bool from_input, int gw, int NGW, int lane_in, float* H, const float* x_in, const float* c_in, const float* gain, const float* modL, int js, int jc, bf16* XN,
                                           const float* SLAB, int nsl, const float* sgate, float scoef, bool s_from_input, bool skipctx, const bf16* DLT) {
    int lane = threadIdx.x; asm volatile("" : "+v"(lane)); lane &= 63; (void)lane_in;
    int cur = -1; f32x4 Av[8], Bv[8];
    for (int r = gw; r < MALL; r += NGW) {
        const int b = r / SB, s = r % SB, mrow = s < 256 ? 2 : b;
        if (skipctx && s < 256) continue;
        if (mrow != cur) { cur = mrow; const f32x4* sc = (const f32x4*)(modL + (size_t)mrow * 18432 + jc * 2048) + lane; const f32x4* sh = (const f32x4*)(modL + (size_t)mrow * 18432 + js * 2048) + lane; const f32x4* gp = (const f32x4*)gain + lane;
#pragma unroll
            for (int j = 0; j < 8; ++j) { Av[j] = gp[64 * j] * (sc[64 * j] + 1.f); Bv[j] = sh[64 * j]; } }
        const bool pend = nsl > 0 && s < 256;
        const float* xrow = (from_input || (pend && s_from_input)) ? (s < 256 ? c_in + ((size_t)b * 256 + s) * 2048 : x_in + ((size_t)b * 8192 + (s - 256)) * 2048) : H + (size_t)r * 2048;
        const GAS f32x4* xr = (const GAS f32x4*)xrow + lane;
        f32x4 v[8];
#pragma unroll
        for (int j = 0; j < 8; ++j) v[j] = xr[64 * j];
        if (DLT && s >= 256) {
            const GAS v2u* dq = (const GAS v2u*)(DLT + (size_t)r * 2048) + lane; GAS f32x4* hw = (GAS f32x4*)(H + (size_t)r * 2048) + lane;
#pragma unroll
            for (int j = 0; j < 8; ++j) { const v2u d = dq[64 * j]; v[j].x += bf2f(d.x & 0xffffu); v[j].y += bf2f(d.x >> 16); v[j].z += bf2f(d.y & 0xffffu); v[j].w += bf2f(d.y >> 16); hw[64 * j] = v[j]; }
        }
        if (pend) {
            f32x4 a[8];
#pragma unroll
            for (int j = 0; j < 8; ++j) a[j] = (f32x4){0.f, 0.f, 0.f, 0.f};
            for (int q = 0; q < nsl; ++q) { const GAS f32x4* sp = (const GAS f32x4*)(SLAB + ((size_t)q * 512 + b * 256 + s) * 2048) + lane;
#pragma unroll
                for (int j = 0; j < 8; ++j) a[j] += sp[64 * j]; }
            const f32x4* gq = (const f32x4*)sgate + lane; GAS f32x4* hw = (GAS f32x4*)(H + (size_t)r * 2048) + lane;
#pragma unroll
            for (int j = 0; j < 8; ++j) { v[j] += gq[64 * j] * scoef * a[j]; hw[64 * j] = v[j]; }
        }
        float ss = 0.f;
#pragma unroll
        for (int j = 0; j < 8; ++j) ss += (v[j].x * v[j].x + v[j].y * v[j].y) + (v[j].z * v[j].z + v[j].w * v[j].w);
        const float rstd = 1.f / sqrtf(wave_sum(ss) * (1.f / 2048.f) + EPS);
        GAS v2u* o8 = (GAS v2u*)(XN + (size_t)r * 2048) + lane;
#pragma unroll
        for (int j = 0; j < 8; ++j) { const f32x4 y = v[j] * rstd * Av[j] + Bv[j]; v2u w; w.x = pk2(y.x, y.y); w.y = pk2(y.z, y.w); o8[64 * j] = w; }
    }
}
__device__ __forceinline__ void final_phase(int gw, int NGW, int lane_in, const float* H, const float* fin, float* out, const bf16* DLT) {
    int lane = threadIdx.x; asm volatile("" : "+v"(lane)); lane &= 63; (void)lane_in;
    f32x4 g[8];
#pragma unroll
    for (int j = 0; j < 8; ++j) g[j] = ((const f32x4*)fin)[lane + 64 * j];
    for (int r = gw; r < NBATCH * SEQ; r += NGW) { const int b = r >> 13, t = r & 8191;
        const GAS f32x4* xr = (const GAS f32x4*)(H + ((size_t)b * SB + 256 + t) * 2048) + lane; const GAS v2u* dq = (const GAS v2u*)(DLT + ((size_t)b * SB + 256 + t) * 2048) + lane; f32x4 v[8]; float ss = 0.f;
#pragma unroll
        for (int j = 0; j < 8; ++j) { v[j] = xr[64 * j]; const v2u d = dq[64 * j]; v[j].x += bf2f(d.x & 0xffffu); v[j].y += bf2f(d.x >> 16); v[j].z += bf2f(d.y & 0xffffu); v[j].w += bf2f(d.y >> 16);
            ss += (v[j].x * v[j].x + v[j].y * v[j].y) + (v[j].z * v[j].z + v[j].w * v[j].w); }
        const float rstd = 1.f / sqrtf(wave_sum(ss) * (1.f / 2048.f) + EPS);
        GAS f32x4* o = (GAS f32x4*)(out + (size_t)r * 2048) + lane;
#pragma unroll
        for (int j = 0; j < 8; ++j) o[64 * j] = v[j] * rstd * g[j]; }
}
__device__ __forceinline__ void qknorm_rope_phase(int gw, int NGW, int lane_in, bf16* QB, bf16* KB, const float* qkn, const f32x2* rope) {
    int lane = threadIdx.x; asm volatile("" : "+v"(lane)); lane &= 63; (void)lane_in;
    const int j = lane & 15;
    for (int r = gw; r < MALL; r += NGW) { const int s = r % SB, b = r / SB;
#pragma unroll
        for (int hg = 3; hg < 4; ++hg) { const int Hh = 4 * hg + (lane >> 4);
            bf16* base = hg < 3 ? QB + (size_t)r * 1536 + Hh * 128 : KB + ((size_t)(b * 4 + (Hh - 12)) * SB + s) * 128; const float* gn = qkn + (hg < 3 ? 0 : 128);
            unsigned a[4]; float x[8];
#pragma unroll
            for (int q = 0; q < 4; ++q) { a[q] = *(const unsigned*)(base + 32 * q + 2 * j); x[2 * q] = bf2f(a[q] & 0xffffu); x[2 * q + 1] = bf2f(a[q] >> 16); }
            float ss = 0.f;
#pragma unroll
            for (int e = 0; e < 8; ++e) ss += x[e] * x[e];
            ss += __shfl_xor(ss, 1); ss += __shfl_xor(ss, 2); ss += __shfl_xor(ss, 4); ss += __shfl_xor(ss, 8);
            const float rs = 1.f / sqrtf(ss * (1.f / 128.f) + EPS);
#pragma unroll
            for (int q = 0; q < 4; ++q) { x[2 * q] *= rs * gn[32 * q + 2 * j]; x[2 * q + 1] *= rs * gn[32 * q + 2 * j + 1]; }
            if (s >= 256) { const f32x2* rp = rope + (size_t)(s - 256) * 64;
#pragma unroll
                for (int ax = 0; ax < 2; ++ax)
#pragma unroll
                    for (int e = 0; e < 2; ++e) { const f32x2 cs = rp[ax * 32 + 2 * j + e]; const float x1 = x[4 * ax + e], x2 = x[4 * ax + 2 + e];
                        x[4 * ax + e] = x1 * cs.x - x2 * cs.y; x[4 * ax + 2 + e] = x1 * cs.y + x2 * cs.x; } }
#pragma unroll
            for (int q = 0; q < 4; ++q) *(unsigned*)(base + 32 * q + 2 * j) = pk2(x[2 * q], x[2 * q + 1]);
        }
    }
}
__device__ __forceinline__ void readout_phase(int gw, int NGW, int lane_in, const bf16* OFW, const bf16* OBW, const bf16* HG, const float* onorm, bf16* XN) {
    int lane = threadIdx.x; asm volatile("" : "+v"(lane)); lane &= 63; (void)lane_in;
    float gn[8];
#pragma unroll
    for (int e = 0; e < 8; ++e) gn[e] = onorm[(8 * lane + e) & 127];
    for (int r = gw; r < MALL; r += NGW) { if (r % SB < 256) continue;
#pragma unroll
        for (int j = 0; j < 4; ++j) { const int col = 8 * lane + 512 * j;
            const size_t ho = ((size_t)(col >> 7) * MALL + r) * 128 + (col & 127);
            const v4u a = *(const GAS v4u*)(OFW + ho), bq = *(const GAS v4u*)(OBW + ho), gq = *(const GAS v4u*)(HG + (size_t)64 * MALL * 128 + ho);
            float o[8], sg[8];
#pragma unroll
            for (int q = 0; q < 4; ++q) { o[2 * q] = bf2f(a[q] & 0xffffu) + bf2f(bq[q] & 0xffffu); o[2 * q + 1] = bf2f(a[q] >> 16) + bf2f(bq[q] >> 16); sg[2 * q] = bf2f(gq[q] & 0xffffu); sg[2 * q + 1] = bf2f(gq[q] >> 16); }
            float ss = 0.f;
#pragma unroll
            for (int e = 0; e < 8; ++e) ss += o[e] * o[e];
            ss += __shfl_xor(ss, 1); ss += __shfl_xor(ss, 2); ss += __shfl_xor(ss, 4); ss += __shfl_xor(ss, 8);
            const float rs = 1.f / sqrtf(ss * (1.f / 128.f) + EPS);
            v4u w;
#pragma unroll
            for (int q = 0; q < 4; ++q) w[q] = pk2(o[2 * q] * rs * gn[2 * q] * sg[2 * q], o[2 * q + 1] * rs * gn[2 * q + 1] * sg[2 * q + 1]);
            *(GAS v4u*)(XN + (size_t)r * 2048 + col) = w; }
    }
}
__device__ __forceinline__ void ctx_dft_phase(LAS unsigned char* lds, int vcu, int G, const bf16* UWC, bf16* MIX) {
    LAS float* tb = (LAS float*)lds;
    int tid_o = threadIdx.x; asm volatile("" : "+v"(tid_o)); const int tid = tid_o;
    __syncthreads();
    if (tid < 256) tb[tid] = cospif((float)tid * (1.f / 128.f));
    __syncthreads();
    for (int e = vcu * 512 + tid; e < 256 * 1024; e += G * 512) { const int k1 = e >> 10, col = e & 1023, b = col >> 9, c = col & 511;
        const GAS v4u* up = (const GAS v4u*)(UWC + (size_t)col * 256); const GAS v4u* wp = (const GAS v4u*)(UWC + (size_t)(1024 + col) * 256);
        float accp = 0.f, accq = 0.f; unsigned j = 0;
        for (int t8 = 0; t8 < 32; ++t8) { const v4u uu = up[t8], ww = wp[t8];
#pragma unroll
            for (int q = 0; q < 4; ++q) {
                accp += bf2f(uu[q] & 0xffffu) * tb[j]; accq += bf2f(ww[q] & 0xffffu) * tb[(j + 192u) & 255u]; j = (j + (unsigned)k1) & 255u;
                accp += bf2f(uu[q] >> 16) * tb[j]; accq += bf2f(ww[q] >> 16) * tb[(j + 192u) & 255u]; j = (j + (unsigned)k1) & 255u; } }
        MIX[((size_t)b * SB + k1) * 2048 + c] = (bf16)f2bf((accp - accq) * 0.0625f); }
    __syncthreads();
}
__device__ __forceinline__ void fft8_prepass(LAS unsigned char* lds, int vcu, int G, const bf16* UWL, bf16* Y) {
    LAS float* ct = (LAS float*)lds;
    int tid_o = threadIdx.x; asm volatile("" : "+v"(tid_o)); const int tid = tid_o;
    __syncthreads();
    for (int j = tid; j < 8192; j += 512) ct[j] = cospif((float)j * (1.f / 4096.f));
    __syncthreads();
    for (int e = vcu * 512 + tid; e < 1024 * 128; e += G * 512) { const int col = e >> 7, o8 = (e & 127) * 8;
        const bf16* up = UWL + (size_t)col * 8192 + o8; const bf16* wp = UWL + (size_t)(1024 + col) * 8192 + o8;
        v4u uu[8], ww[8];
#pragma unroll
        for (int s = 0; s < 8; ++s) { uu[s] = *(const GAS v4u*)(up + 1024 * s); ww[s] = *(const GAS v4u*)(wp + 1024 * s); }
        v4u ore[8], oim[8];
#pragma unroll
        for (int qp = 0; qp < 4; ++qp) { float yr[2][8], yi[2][8];
#pragma unroll
            for (int hq = 0; hq < 2; ++hq) { float zr[8], zi[8];
#pragma unroll
                for (int s = 0; s < 8; ++s) { zr[s] = bf2f(hq ? (uu[s][qp] >> 16) : (uu[s][qp] & 0xffffu)); zi[s] = -bf2f(hq ? (ww[s][qp] >> 16) : (ww[s][qp] & 0xffffu)); }
                float er[4], ei[4], dr[4], di[4];
                { const float ar = zr[0] + zr[4], ai = zi[0] + zi[4], br = zr[0] - zr[4], bi = zi[0] - zi[4], cr = zr[2] + zr[6], ci = zi[2] + zi[6], fr_ = zr[2] - zr[6], fi = zi[2] - zi[6];
                  er[0] = ar + cr; ei[0] = ai + ci; er[2] = ar - cr; ei[2] = ai - ci; er[1] = br + fi; ei[1] = bi - fr_; er[3] = br - fi; ei[3] = bi + fr_; }
                { const float ar = zr[1] + zr[5], ai = zi[1] + zi[5], br = zr[1] - zr[5], bi = zi[1] - zi[5], cr = zr[3] + zr[7], ci = zi[3] + zi[7], fr_ = zr[3] - zr[7], fi = zi[3] - zi[7];
                  dr[0] = ar + cr; di[0] = ai + ci; dr[2] = ar - cr; di[2] = ai - ci; dr[1] = br + fi; di[1] = bi - fr_; dr[3] = br - fi; di[3] = bi + fr_; }
                const float R2 = 0.70710678118654752f;
                float tr[4], ti[4];
                tr[0] = dr[0]; ti[0] = di[0];
                tr[1] = (dr[1] + di[1]) * R2; ti[1] = (di[1] - dr[1]) * R2;
                tr[2] = di[2]; ti[2] = -dr[2];
                tr[3] = (di[3] - dr[3]) * R2; ti[3] = (-di[3] - dr[3]) * R2;
                const unsigned tpp = (unsigned)(o8 + 2 * qp + hq);
#pragma unroll
                for (int m = 0; m < 4; ++m) {
#pragma unroll
                    for (int hh = 0; hh < 2; ++hh) { const int kap = m + 4 * hh; const float ar = hh ? er[m] - tr[m] : er[m] + tr[m], ai = hh ? ei[m] - ti[m] : ei[m] + ti[m];
                        const unsigned j = (unsigned)kap * tpp; const float c = ct[j], sn = ct[(j + 6144u) & 8191u];
                        yr[hq][kap] = ar * c + ai * sn; yi[hq][kap] = ai * c - ar * sn; } }
            }
#pragma unroll
            for (int kap = 0; kap < 8; ++kap) { ore[kap][qp] = pg8::cvt_pk_bf16(yr[0][kap], yr[1][kap]); oim[kap][qp] = pg8::cvt_pk_bf16(yi[0][kap], yi[1][kap]); }
        }
#pragma unroll
        for (int kap = 0; kap < 8; ++kap) { bf16* yp = Y + ((size_t)(kap * 1024 + col)) * 2048 + o8; *(GAS v4u*)yp = ore[kap]; *(GAS v4u*)(yp + 1024) = oim[kap]; }
    }
    __syncthreads();
}


__device__ __forceinline__ int crow(int r, int hi) { return (r & 3) + 8 * (r >> 2) + 4 * hi; }
__device__ __forceinline__ bf16x8 pack8(const f32x16& x, int s8) {
    v4u w; w.x = pg8::cvt_pk_bf16(x[s8 + 0], x[s8 + 1]); w.y = pg8::cvt_pk_bf16(x[s8 + 2], x[s8 + 3]); w.z = pg8::cvt_pk_bf16(x[s8 + 4], x[s8 + 5]); w.w = pg8::cvt_pk_bf16(x[s8 + 6], x[s8 + 7]);
    return __builtin_bit_cast(bf16x8, w);
}
__device__ __forceinline__ bf16x8 ld_b128(const LAS unsigned char* p) { return *(const LAS bf16x8*)p; }
__device__ __forceinline__ bf16x8 ld_2xb64(const LAS unsigned char* p0, const LAS unsigned char* p1) { const v2u a = *(const LAS v2u*)p0, b = *(const LAS v2u*)p1; v4u w; w.x = a.x; w.y = a.y; w.z = b.x; w.w = b.y; return __builtin_bit_cast(bf16x8, w); }
__device__ __forceinline__ unsigned off_b(unsigned row, unsigned ch) { return 256u * row + 16u * (ch ^ (((row & 3u) << 2) | ((row >> 2) & 3u))); }
typedef short v4i16_t __attribute__((ext_vector_type(4)));
__device__ __forceinline__ s16x4 vtr(const LAS unsigned char* p) { return __builtin_bit_cast(s16x4, __builtin_amdgcn_ds_read_tr16_b64_v4i16((LAS v4i16_t*)p)); }
__device__ __forceinline__ bf16x8 tr_pair(const LAS unsigned char* img, unsigned rowA, unsigned rowB, unsigned cblk, unsigned lane) {
    const unsigned blk = (lane >> 4) & 1u, q = (lane & 15u) >> 2, p = lane & 3u, ch = 4u * cblk + 2u * blk + (p >> 1), sub = 8u * (p & 1u);
    const s16x4 lo = vtr(img + off_b(rowA + q, ch) + sub), hi4 = vtr(img + off_b(rowB + q, ch) + sub);
    return (bf16x8){lo[0], lo[1], lo[2], lo[3], hi4[0], hi4[1], hi4[2], hi4[3]};
}
constexpr int SC_Q1 = 0, SC_K1 = 16384, SC_V = 32768, SC_TOT = 49152, SC_EBL = 57344, SC_HALF = 57856;
template <bool FULL>
__device__ __forceinline__ void hgrn_scan(LAS unsigned char* lds, int vcu, int G, const bf16* HG, float* USEG, float* DSEG, bf16* OFW, bf16* OBW, int probe = 0) {
    int tid_o = threadIdx.x; asm volatile("" : "+v"(tid_o));
    const int tid = tid_o, half = __builtin_amdgcn_readfirstlane(tid >> 8), ht = tid & 255, w = __builtin_amdgcn_readfirstlane((tid >> 6) & 3), lane = tid & 63, l31 = lane & 31, hi = lane >> 5;
    LAS unsigned char* base = lds + half * SC_HALF;
    LAS unsigned char* Q1 = base + SC_Q1;
    LAS unsigned char* K1 = base + SC_K1;
    LAS unsigned char* Vi = base + SC_V;
    LAS float* TOT = (LAS float*)(base + SC_TOT);
    LAS float* EBL = (LAS float*)(base + SC_EBL);
    const int cg = ht & 15, rg = ht >> 4, dir = half;
    bf16* OD = dir ? OBW : OFW;
    for (int wi = vcu; wi < (FULL ? 1024 : 1056); wi += G) {
        const int b = FULL ? wi >> 9 : wi / 528, rem = FULL ? wi & 511 : wi % 528, h = FULL ? rem >> 5 : rem / 33, p = FULL ? (rem & 31) + 1 : rem % 33;
        const int it = ((b * 16 + h) * 2 + dir) * 33 + p;
        const size_t row0 = (size_t)b * SB + (size_t)p * 256;
        f32x16 S[4];
        if (FULL) {
#pragma unroll
            for (int kb = 0; kb < 4; ++kb)
#pragma unroll
                for (int r8 = 0; r8 < 2; ++r8) { const v4u t = *(const GAS v4u*)((const bf16*)USEG + (size_t)it * 16384 + (size_t)((w * 4 + kb) * 64 + lane) * 16 + 8 * r8);
#pragma unroll
                    for (int q = 0; q < 4; ++q) { S[kb][8 * r8 + 2 * q] = bf2f(t[q] & 0xffffu); S[kb][8 * r8 + 2 * q + 1] = bf2f(t[q] >> 16); } }
        } else {
#pragma unroll
            for (int kb = 0; kb < 4; ++kb)
#pragma unroll
                for (int r = 0; r < 16; ++r) S[kb][r] = 0.f;
        }
        float dtot[8];
#pragma unroll
        for (int e = 0; e < 8; ++e) dtot[e] = 1.f;
        v4u lfq[4], qq[4], vq[4];
#define SC_LOAD(jj) do { _Pragma("unroll") for (int i = 0; i < 4; ++i) { const int tl = 64 * (jj) + 4 * rg + i; const bf16* rp = HG + ((size_t)((1 + dir) * 16 + h) * MALL + row0 + (dir ? 255 - tl : tl)) * 128 + 8 * cg; \
                    lfq[i] = *(const GAS v4u*)rp; } } while (0)
        SC_LOAD(0);
        for (int j = 0; j < 4; ++j) {
            v4u lfk[4];
            {
#pragma unroll
                for (int i = 0; i < 4; ++i) { lfk[i] = lfq[i]; const int tl = 64 * j + 4 * rg + i; const size_t ro = ((size_t)h * MALL + row0 + (dir ? 255 - tl : tl)) * 128 + 8 * cg; vq[i] = *(const GAS v4u*)(HG + (size_t)48 * MALL * 128 + ro); if (FULL) qq[i] = *(const GAS v4u*)(HG + ro); }
                float run[8];
#pragma unroll
                for (int e = 0; e < 8; ++e) run[e] = 1.f;
#pragma unroll
                for (int i = 0; i < 4; ++i)
#pragma unroll
                    for (int e = 0; e < 8; ++e) { const unsigned u = (e & 1) ? (lfk[i][e >> 1] >> 16) : (lfk[i][e >> 1] & 0xffffu); run[e] *= (float)u * (1.f / 65535.f); }
                *(LAS f32x4*)(TOT + rg * 128 + 8 * cg) = (f32x4){run[0], run[1], run[2], run[3]}; *(LAS f32x4*)(TOT + rg * 128 + 8 * cg + 4) = (f32x4){run[4], run[5], run[6], run[7]};
            }
            __syncthreads();
            {
                if (ht < 128 && !(probe & 8)) { float t[16];
#pragma unroll
                    for (int g2 = 0; g2 < 16; ++g2) t[g2] = TOT[g2 * 128 + ht];
                    float ex = 1.f;
#pragma unroll
                    for (int g2 = 0; g2 < 16; ++g2) { TOT[g2 * 128 + ht] = ex; ex *= t[g2]; }
                    EBL[ht] = ex; }
                __syncthreads();
                float off[8], bl[8];
                { const f32x4 p0 = *(const LAS f32x4*)(TOT + rg * 128 + 8 * cg), p1 = *(const LAS f32x4*)(TOT + rg * 128 + 8 * cg + 4), b0 = *(const LAS f32x4*)(EBL + 8 * cg), b1 = *(const LAS f32x4*)(EBL + 8 * cg + 4);
#pragma unroll
                  for (int e = 0; e < 4; ++e) { off[e] = p0[e]; off[4 + e] = p1[e]; bl[e] = b0[e]; bl[4 + e] = b1[e]; } }
#pragma unroll
                for (int e = 0; e < 8; ++e) dtot[e] *= bl[e];
                if (!(probe & 4))
#pragma unroll
                for (int i = 0; i < 4; ++i) { float k1[8], q1[8];
#pragma unroll
                    for (int e = 0; e < 8; ++e) { const unsigned u = (e & 1) ? (lfk[i][e >> 1] >> 16) : (lfk[i][e >> 1] & 0xffffu); const float fd = (float)u * (1.f / 65535.f); off[e] = fmaxf(off[e] * fd, 1e-30f);
                        k1[e] = (1.f - fd) * __builtin_amdgcn_rcpf(off[e]);
                        if (FULL) { const unsigned qu = (e & 1) ? (qq[i][e >> 1] >> 16) : (qq[i][e >> 1] & 0xffffu); q1[e] = bf2f(qu) * off[e]; } }
                    v4u o; o.x = pg8::cvt_pk_bf16(k1[0], k1[1]); o.y = pg8::cvt_pk_bf16(k1[2], k1[3]); o.z = pg8::cvt_pk_bf16(k1[4], k1[5]); o.w = pg8::cvt_pk_bf16(k1[6], k1[7]);
                    *(LAS v4u*)(K1 + off_b(4 * rg + i, cg)) = o; *(LAS v4u*)(Vi + off_b(4 * rg + i, cg)) = vq[i];
                    if (FULL) { v4u o2; o2.x = pg8::cvt_pk_bf16(q1[0], q1[1]); o2.y = pg8::cvt_pk_bf16(q1[2], q1[3]); o2.z = pg8::cvt_pk_bf16(q1[4], q1[5]); o2.w = pg8::cvt_pk_bf16(q1[6], q1[7]);
                        *(LAS v4u*)(Q1 + off_b(4 * rg + i, cg)) = o2; }
                    asm volatile("" ::: "memory"); }
                if (j < 3) SC_LOAD(j + 1);
            }
            __syncthreads();
            f32x16 o0, o1;
            if (FULL && !(probe & 1)) {
#pragma unroll
                for (int r = 0; r < 16; ++r) { o0[r] = 0.f; o1[r] = 0.f; }
#pragma unroll
                for (int blk = 0; blk < 3; ++blk) { const int sb_ = blk == 2 ? 1 : 0, tb_ = blk == 0 ? 0 : 1;
                    f32x16 X;
#pragma unroll
                    for (int r = 0; r < 16; ++r) X[r] = 0.f;
#pragma unroll 4
                    for (int ks = 0; ks < 8; ++ks) X = __builtin_amdgcn_mfma_f32_32x32x16_bf16(ld_b128(K1 + off_b(32 * sb_ + l31, 2 * ks + hi)), ld_b128(Q1 + off_b(32 * tb_ + l31, 2 * ks + hi)), X, 0, 0, 0);
                    if (sb_ == tb_) {
#pragma unroll
                        for (int r = 0; r < 16; ++r) X[r] = crow(r, hi) <= l31 ? X[r] : 0.f; }
#pragma unroll
                    for (int sp = 0; sp < 2; ++sp) { const bf16x8 vb = tr_pair(Vi, 32 * sb_ + 16 * sp + 4 * hi, 32 * sb_ + 16 * sp + 4 * hi + 8, w, lane);
                        if (tb_ == 0) o0 = __builtin_amdgcn_mfma_f32_32x32x16_bf16(pack8(X, 8 * sp), vb, o0, 0, 0, 0); else o1 = __builtin_amdgcn_mfma_f32_32x32x16_bf16(pack8(X, 8 * sp), vb, o1, 0, 0, 0); }
                    asm volatile("" ::: "memory"); }
#pragma unroll
                for (int kb = 0; kb < 4; ++kb)
#pragma unroll
                    for (int sp = 0; sp < 2; ++sp) { asm volatile("" ::: "memory"); const bf16x8 sb = pack8(S[kb], 8 * sp); const unsigned ch = 4 * kb + 2 * sp, sub = 8 * hi;
                        const bf16x8 qa0 = ld_2xb64(Q1 + off_b(l31, ch) + sub, Q1 + off_b(l31, ch + 1) + sub), qa1 = ld_2xb64(Q1 + off_b(32 + l31, ch) + sub, Q1 + off_b(32 + l31, ch + 1) + sub);
                        o0 = __builtin_amdgcn_mfma_f32_32x32x16_bf16(qa0, sb, o0, 0, 0, 0);
                        o1 = __builtin_amdgcn_mfma_f32_32x32x16_bf16(qa1, sb, o1, 0, 0, 0); }
            }
            if ((!FULL || j < 3) && !(probe & 1)) {
#pragma unroll
                for (int st = 0; st < 4; ++st) { const bf16x8 vb = tr_pair(Vi, 16 * st + 8 * hi, 16 * st + 8 * hi + 4, w, lane);
#pragma unroll
                    for (int kb = 0; kb < 4; ++kb) S[kb] = __builtin_amdgcn_mfma_f32_32x32x16_bf16(tr_pair(K1, 16 * st + 8 * hi, 16 * st + 8 * hi + 4, kb, lane), vb, S[kb], 0, 0, 0); }
#pragma unroll
                for (int kb = 0; kb < 4; ++kb)
#pragma unroll
                    for (int r4 = 0; r4 < 4; ++r4) { const f32x4 eb = *(const LAS f32x4*)(EBL + 32 * kb + 8 * r4 + 4 * hi);
#pragma unroll
                        for (int e = 0; e < 4; ++e) S[kb][4 * r4 + e] *= eb[e]; }
            }
            __syncthreads();
            if (FULL && !(probe & 2)) {
#pragma unroll
                for (int r = 0; r < 16; ++r) { const int t0 = crow(r, hi);
                    *(LAS bf16*)(Q1 + t0 * 256 + (32 * w + l31) * 2) = (bf16)pg8::cvt_pk_bf16(o0[r], 0.f); *(LAS bf16*)(Q1 + (32 + t0) * 256 + (32 * w + l31) * 2) = (bf16)pg8::cvt_pk_bf16(o1[r], 0.f); }
                __syncthreads();
#pragma unroll
                for (int i = 0; i < 4; ++i) { const int tl = 64 * j + 4 * rg + i; *(GAS v4u*)(OD + ((size_t)h * MALL + row0 + (dir ? 255 - tl : tl)) * 128 + 8 * cg) = *(const LAS v4u*)(Q1 + (4 * rg + i) * 256 + 16 * cg); }
            }
        }
        if (!FULL && !(probe & 2)) {
#pragma unroll
            for (int kb = 0; kb < 4; ++kb)
#pragma unroll
                for (int r8 = 0; r8 < 2; ++r8) { v4u t;
#pragma unroll
                    for (int q = 0; q < 4; ++q) t[q] = pg8::cvt_pk_bf16(S[kb][8 * r8 + 2 * q], S[kb][8 * r8 + 2 * q + 1]);
                    *(GAS v4u*)((bf16*)USEG + (size_t)it * 16384 + (size_t)((w * 4 + kb) * 64 + lane) * 16 + 8 * r8) = t; }
            if (rg == 0) { float* dp = DSEG + it * 128 + 8 * cg; *(f32x4*)dp = (f32x4){dtot[0], dtot[1], dtot[2], dtot[3]}; *(f32x4*)(dp + 4) = (f32x4){dtot[4], dtot[5], dtot[6], dtot[7]}; }
        }
    }
}
#undef SC_LOAD
__device__ __forceinline__ void hgrn_combine(int vcu, int G, float* USEG_f, const float* DSEG) {
    int tid_o = threadIdx.x; asm volatile("" : "+v"(tid_o));
    bf16* USEG = (bf16*)USEG_f;
    const int gt = vcu * 512 + tid_o, NT = G * 512;
    for (int e8 = gt; e8 < 64 * 2048; e8 += NT) { const int chain = e8 >> 11, idx8 = e8 & 2047, dir = chain & 1;
        const int k0 = 32 * ((idx8 >> 7) & 3) + 16 * (idx8 & 1) + 4 * ((idx8 >> 6) & 1);
        float carry[8];
#pragma unroll
        for (int e = 0; e < 8; ++e) carry[e] = 0.f;
        for (int i0 = 0; i0 < 33; i0 += 11) { v4u t[11]; f32x4 d0[11], d1[11];
#pragma unroll
            for (int i = 0; i < 11; ++i) { const int ii = i0 + i, p = (dir == 0 || ii == 0) ? ii : 33 - ii; t[i] = *(const GAS v4u*)(USEG + ((size_t)(chain * 33 + p) * 2048 + idx8) * 8);
                d0[i] = *(const f32x4*)(DSEG + (chain * 33 + p) * 128 + k0); d1[i] = *(const f32x4*)(DSEG + (chain * 33 + p) * 128 + k0 + 8); }
#pragma unroll
            for (int i = 0; i < 11; ++i) { const int ii = i0 + i, p = (dir == 0 || ii == 0) ? ii : 33 - ii; v4u o;
#pragma unroll
                for (int q = 0; q < 4; ++q) o[q] = pg8::cvt_pk_bf16(carry[2 * q], carry[2 * q + 1]);
                *(GAS v4u*)(USEG + ((size_t)(chain * 33 + p) * 2048 + idx8) * 8) = o;
#pragma unroll
                for (int q = 0; q < 4; ++q) { const float dl = q < 2 ? d0[i][2 * q] : d1[i][2 * q - 4], dh = q < 2 ? d0[i][2 * q + 1] : d1[i][2 * q - 3];
                    carry[2 * q] = carry[2 * q] * dl + bf2f(t[i][q] & 0xffffu); carry[2 * q + 1] = carry[2 * q + 1] * dh + bf2f(t[i][q] >> 16); } }
        }
    }
}
__global__ void __launch_bounds__(NWAVES * 64, 2) mk_fwd(Args args) {
    extern __shared__ __attribute__((aligned(16))) unsigned char lds_raw[];
    LAS unsigned char* lds = (LAS unsigned char*)lds_raw;
    const int tid = threadIdx.x, lane = 0, wave = __builtin_amdgcn_readfirstlane(tid >> 6);
    const int G = gridDim.x, bx = blockIdx.x, vcu = (G % 8 == 0) ? (bx % 8) * (G / 8) + bx / 8 : bx;
    const int gw = vcu * NWAVES + wave, NGW = G * NWAVES;
    unsigned char* ws = args.ws;
    volatile LAS unsigned* MISC = (volatile LAS unsigned*)(lds + MISC_OFF);
    for (int u = tid; u < (LDS_BYTES - MISC_OFF) / 4; u += NWAVES * 64) ((LAS unsigned*)(lds + MISC_OFF))[u] = 0u;
    __syncthreads();
    unsigned* ctl = (unsigned*)(ws + WS_CTL);
    XcdBarrier bar; bar.bar = ctl + CW_BAR; bar.x = 0; bar.st = nullptr;
    if (!MK_SPLIT) bar = xcd_barrier_post(ctl + CW_BAR, MISC + 8);
#define GRID_BAR() do { if (!MK_SPLIT) xcd_barrier(bar); } while (0)
    const int lo = args.ph_lo, hi = args.ph_hi; (void)lo; (void)hi;
#ifndef ONLY_SITE
#define ONLY_SITE -1
#endif
#if MK_SPLIT
#define INS(site, k) ((ONLY_SITE < 0 || ONLY_SITE == (site)) && lo <= (k) && (k) < hi)
#else
#define INS(site, k) (ONLY_SITE < 0 || ONLY_SITE == (site))
#endif
#ifndef DUP_MASK
#define DUP_MASK 0
#endif
#ifndef DUP_N
#define DUP_N 1
#endif
#ifndef RES_ALIGN
#define RES_ALIGN true
#endif
#ifndef FFN_ALIGN
#define FFN_ALIGN true
#endif
#ifndef FFN_SP2
#define FFN_SP2 true
#endif
#ifndef PROBE_SCAN
#define PROBE_SCAN 0
#endif
#define REPS(site) for (int rep = 0; rep < 1 + (((DUP_MASK >> (site)) & 1) ? DUP_N : 0); ++rep)
#define H_ ((float*)(ws + WS_H))
#define XN_ ((bf16*)(ws + WS_XN))
#define HID_ ((bf16*)(ws + WS_HID))
#define MOD_ ((float*)(ws + WS_MOD))
#define MIX_ ((bf16*)(ws + WS_MIX))
#define QB_ ((bf16*)(ws + WS_QB))
#define KB_ ((bf16*)(ws + WS_KB))
#define VB_ ((bf16*)(ws + WS_VB))
#define HG_ ((bf16*)(ws + WS_HG))
#define OFW_ ((bf16*)(ws + WS_OFW))
#define OBW_ ((bf16*)(ws + WS_OBW))
#define USEG_ ((float*)(ws + WS_USEG))
#define DSEG_ ((float*)(ws + WS_DSEG))
#define SLAB_ ((float*)(ws + WS_SLAB))
#define DLT_ ((bf16*)(ws + WS_DLT))
    if (INS(0, 0)) REPS(0) { prologue_phase(args, lds, vcu, G, rep); GRID_BAR(); }

    {
        constexpr int f = 0;
        const int layer = f >> 1, sub = f & 1;
        const float* modL = MOD_ + (size_t)layer * 3 * 18432;
        const float* gainL = args.in[6] + (size_t)layer * 3 * 2048;
        if (sub == 1) {
            const int mb = layer == 0 ? 4 : 15;
            if (INS(1, mb)) REPS(1) { norm_phase(layer == 0 && !rep, gw, NGW, lane, H_, args.in[0], args.in[2], gainL + 2048, modL, 3, 4, XN_, SLAB_, rep ? 0 : 11, modL + 2 * 18432 + 2 * 2048, 0.5f, layer == 0, false, rep ? nullptr : DLT_); GRID_BAR(); }
            if (layer == 0) {
                if (INS(2, 5)) REPS(2) {
                    const bf16* wqkv = (const bf16*)(ws + WS_WABIN) + (size_t)1024 * 2048; const bf16* wf = (const bf16*)(ws + WS_WABIN);
                    pg8::Gemm g{XN_, wqkv, 2048, 2048, (size_t)((const char*)wf - (const char*)XN_), (size_t)((const char*)XN_ - (const char*)wqkv)};
                    pg8::ABOrder S; S.so.init(MALL, 2560, 2048, G, bx); S.G = G; S.c = bx;
                    pg8::EpiAB E{(bf16*)(ws + WS_UWL), (bf16*)(ws + WS_UWC), QB_, KB_, VB_};
                    pg8::gemm_phase<pg8::EpiAB, pg8::ABOrder, true, true>(lds, g, S, E);
                    GRID_BAR(); }
                if (INS(3, 6)) REPS(3) { qknorm_rope_phase(gw, NGW, lane, QB_, KB_, args.in[10], (const f32x2*)(ws + WS_ROPE)); fft8_prepass(lds, vcu, G, (const bf16*)(ws + WS_UWL), (bf16*)(ws + WS_DFT)); GRID_BAR(); }
                if (INS(4, 7) || (ONLY_SITE == 15 || ONLY_SITE == 16)) REPS(4) {
#ifndef PROBE_ATT
#define PROBE_ATT 3
#endif
                    if (ONLY_SITE != 15 && (!rep || (PROBE_ATT & 1))) for (int i = 0;; ++i) { const int L = i * G + vcu; if (L >= 792) break;
                        int b, hq, seq; size_t qrow; const float* ropeb;
                        if (L < 768) { b = L / 384; const int rem = L % 384; hq = rem >> 5; qrow = (size_t)b * SB + 256 + (size_t)(rem & 31) * 256; seq = SB; ropeb = (const float*)(ws + WS_ROPE) + (size_t)(rem & 31) * 256 * 128; }
                        else { const int jx = L - 768; b = jx / 12; hq = jx % 12; qrow = (size_t)b * SB; seq = 256; ropeb = nullptr; }
                        const size_t kvoff = (size_t)(b * 4 + hq / 3) * SB * 128;
                        attn::attn_dense_body<attn::bf16>((const attn::bf16*)(QB_ + qrow * 1536 + hq * 128), (const attn::bf16*)(KB_ + kvoff), (const attn::bf16*)(VB_ + kvoff), MIX_ + qrow * 2048 + 512 + hq * 128, seq, (char*)lds_raw, args.in[10], ropeb);
                        __syncthreads(); }
                    __syncthreads();
                    if (ONLY_SITE != 16 && (!rep || (PROBE_ATT & 2))) { pg8::Gemm g{(const bf16*)(ws + WS_DFTA), (const bf16*)(ws + WS_DFT), 2048, 2048, 0, 0};
                      pg8::DftOrder S{4, 32, 1, G, bx, 2048 / 64}; pg8::EpiDFT E{MIX_, 0.011048543456039806f};
                      pg8::gemm_phase<pg8::EpiDFT, pg8::DftOrder, true, true>(lds, g, S, E); }
                    if (ONLY_SITE != 16) { if (G == 256) { if (bx >= 128) ctx_dft_phase(lds, bx - 128, 128, (const bf16*)(ws + WS_UWC), MIX_); }
                                           else ctx_dft_phase(lds, vcu, G, (const bf16*)(ws + WS_UWC), MIX_); }
                    GRID_BAR(); }
            } else {
                if (INS(5, 16)) REPS(5) {
                    pg8::Gemm g{XN_, (const bf16*)(ws + WS_WHGIN), 2048, 2048, 0, 0}; pg8::StaticOrder S; S.init(MALL, 10240, 2048, G, bx);
                    pg8::EpiHG E{HG_, args.in[13]};
                    pg8::gemm_phase<pg8::EpiHG, pg8::StaticOrder, true, true>(lds, g, S, E);
                    GRID_BAR(); }
                if (INS(6, 17)) REPS(6) { hgrn_scan<false>(lds, vcu, G, HG_, USEG_, DSEG_, OFW_, OBW_, rep ? PROBE_SCAN : 0); GRID_BAR(); }
                if (INS(7, 18)) REPS(7) { hgrn_combine(vcu, G, USEG_, DSEG_); GRID_BAR(); }
                if (INS(8, 19)) REPS(8) { hgrn_scan<true>(lds, vcu, G, HG_, USEG_, DSEG_, OFW_, OBW_, rep ? PROBE_SCAN : 0); GRID_BAR(); }
                if (INS(9, 20)) REPS(9) { readout_phase(gw, NGW, lane, OFW_, OBW_, HG_, args.in[14], XN_); GRID_BAR(); }
            }
            if (INS(10, mb + (layer == 0 ? 4 : 6))) REPS(10) {
                pg8::Gemm g; int Kk; if (layer == 0) { g = pg8::Gemm{MIX_, (const bf16*)(ws + WS_WABOUT), 2048, 2048, 0, 0}; Kk = 2048; } else { g = pg8::Gemm{XN_, (const bf16*)(ws + WS_WHGOUT), 2048, 2048, 0, 0}; Kk = 2048; }
                pg8::ResidOrder S; S.so.init(MALL, 2048, Kk, G, bx, 1); S.nsl = layer == 0 ? 4 : 0;
                pg8::EpiResid E{rep ? XN_ : DLT_, modL + 5 * 2048, 1.f, SLAB_, rep};
                pg8::gemm_phase<pg8::EpiResid, pg8::ResidOrder, RES_ALIGN, true>(lds, g, S, E);
                GRID_BAR(); }
        }
        const int pb = f == 0 ? 1 : f == 1 ? 9 : f == 2 ? 12 : 22;
        const int jb = sub == 0 ? 0 : 6;
        if (INS(11, pb)) REPS(11) {
            const float* sg = f == 1 ? modL + 2 * 18432 + 5 * 2048 : MOD_ + 2 * 18432 + 8 * 2048;
            norm_phase(f == 0, gw, NGW, lane, H_, args.in[0], args.in[2], gainL + (sub == 0 ? 0 : 2) * 2048, modL, jb, jb + 1, XN_, SLAB_, rep ? 0 : f == 1 ? 4 : f == 2 ? 11 : 0, sg, f == 1 ? 1.f : 0.5f, false, f == 3, (f == 0 || rep) ? nullptr : DLT_); GRID_BAR(); }
        if (INS(12, pb + 1)) REPS(12) {
            pg8::Gemm g{XN_, (const bf16*)(ws + WS_WFIN) + (size_t)f * 11264 * 2048, 2048, 2048, 0, 0}; pg8::StaticOrder S; S.init(MALL, 11264, 2048, G, bx, f == 3);
            pg8::EpiSwiGLU E{HID_, FFD};
            pg8::gemm_phase<pg8::EpiSwiGLU, pg8::StaticOrder, FFN_ALIGN, FFN_SP2>(lds, g, S, E);
            GRID_BAR(); }
        if (INS(13, pb + 2)) REPS(13) {
            pg8::Gemm g{HID_, (const bf16*)(ws + WS_WFOUT) + (size_t)f * 2048 * FFD, 64, FFD, 0, 0, (size_t)256 * 64 * 2, (size_t)(FFD / 64) * 256 * 64 * 2};
#ifdef PROBE_SAMEA
            if (rep) g.tstA = 64;
#endif
            pg8::ResidOrder S; S.so.init(MALL, 2048, FFD, G, bx, 1); S.nsl = f == 3 ? 0 : 11;
            pg8::EpiResid E{rep ? XN_ : DLT_, modL + (jb + 2) * 2048, 0.5f, SLAB_, rep};
            pg8::gemm_phase<pg8::EpiResid, pg8::ResidOrder, RES_ALIGN, true>(lds, g, S, E);
            GRID_BAR(); }
        }
    {
        constexpr int f = 1;
        const int layer = f >> 1, sub = f & 1;
        const float* modL = MOD_ + (size_t)layer * 3 * 18432;
        const float* gainL = args.in[6] + (size_t)layer * 3 * 2048;
        if (sub == 1) {
            const int mb = layer == 0 ? 4 : 15;
            if (INS(1, mb)) REPS(1) { norm_phase(layer == 0 && !rep, gw, NGW, lane, H_, args.in[0], args.in[2], gainL + 2048, modL, 3, 4, XN_, SLAB_, rep ? 0 : 11, modL + 2 * 18432 + 2 * 2048, 0.5f, layer == 0, false, rep ? nullptr : DLT_); GRID_BAR(); }
            if (layer == 0) {
                if (INS(2, 5)) REPS(2) {
                    const bf16* wqkv = (const bf16*)(ws + WS_WABIN) + (size_t)1024 * 2048; const bf16* wf = (const bf16*)(ws + WS_WABIN);
                    pg8::Gemm g{XN_, wqkv, 2048, 2048, (size_t)((const char*)wf - (const char*)XN_), (size_t)((const char*)XN_ - (const char*)wqkv)};
                    pg8::ABOrder S; S.so.init(MALL, 2560, 2048, G, bx); S.G = G; S.c = bx;
                    pg8::EpiAB E{(bf16*)(ws + WS_UWL), (bf16*)(ws + WS_UWC), QB_, KB_, VB_};
                    pg8::gemm_phase<pg8::EpiAB, pg8::ABOrder, true, true>(lds, g, S, E);
                    GRID_BAR(); }
                if (INS(3, 6)) REPS(3) { qknorm_rope_phase(gw, NGW, lane, QB_, KB_, args.in[10], (const f32x2*)(ws + WS_ROPE)); fft8_prepass(lds, vcu, G, (const bf16*)(ws + WS_UWL), (bf16*)(ws + WS_DFT)); GRID_BAR(); }
                if (INS(4, 7) || (ONLY_SITE == 15 || ONLY_SITE == 16)) REPS(4) {
#ifndef PROBE_ATT
#define PROBE_ATT 3
#endif
                    if (ONLY_SITE != 15 && (!rep || (PROBE_ATT & 1))) for (int i = 0;; ++i) { const int L = i * G + vcu; if (L >= 792) break;
                        int b, hq, seq; size_t qrow; const float* ropeb;
                        if (L < 768) { b = L / 384; const int rem = L % 384; hq = rem >> 5; qrow = (size_t)b * SB + 256 + (size_t)(rem & 31) * 256; seq = SB; ropeb = (const float*)(ws + WS_ROPE) + (size_t)(rem & 31) * 256 * 128; }
                        else { const int jx = L - 768; b = jx / 12; hq = jx % 12; qrow = (size_t)b * SB; seq = 256; ropeb = nullptr; }
                        const size_t kvoff = (size_t)(b * 4 + hq / 3) * SB * 128;
                        attn::attn_dense_body<attn::bf16>((const attn::bf16*)(QB_ + qrow * 1536 + hq * 128), (const attn::bf16*)(KB_ + kvoff), (const attn::bf16*)(VB_ + kvoff), MIX_ + qrow * 2048 + 512 + hq * 128, seq, (char*)lds_raw, args.in[10], ropeb);
                        __syncthreads(); }
                    __syncthreads();
                    if (ONLY_SITE != 16 && (!rep || (PROBE_ATT & 2))) { pg8::Gemm g{(const bf16*)(ws + WS_DFTA), (const bf16*)(ws + WS_DFT), 2048, 2048, 0, 0};
                      pg8::DftOrder S{4, 32, 1, G, bx, 2048 / 64}; pg8::EpiDFT E{MIX_, 0.011048543456039806f};
                      pg8::gemm_phase<pg8::EpiDFT, pg8::DftOrder, true, true>(lds, g, S, E); }
                    if (ONLY_SITE != 16) { if (G == 256) { if (bx >= 128) ctx_dft_phase(lds, bx - 128, 128, (const bf16*)(ws + WS_UWC), MIX_); }
                                           else ctx_dft_phase(lds, vcu, G, (const bf16*)(ws + WS_UWC), MIX_); }
                    GRID_BAR(); }
            } else {
                if (INS(5, 16)) REPS(5) {
                    pg8::Gemm g{XN_, (const bf16*)(ws + WS_WHGIN), 2048, 2048, 0, 0}; pg8::StaticOrder S; S.init(MALL, 10240, 2048, G, bx);
                    pg8::EpiHG E{HG_, args.in[13]};
                    pg8::gemm_phase<pg8::EpiHG, pg8::StaticOrder, true, true>(lds, g, S, E);
                    GRID_BAR(); }
                if (INS(6, 17)) REPS(6) { hgrn_scan<false>(lds, vcu, G, HG_, USEG_, DSEG_, OFW_, OBW_, rep ? PROBE_SCAN : 0); GRID_BAR(); }
                if (INS(7, 18)) REPS(7) { hgrn_combine(vcu, G, USEG_, DSEG_); GRID_BAR(); }
                if (INS(8, 19)) REPS(8) { hgrn_scan<true>(lds, vcu, G, HG_, USEG_, DSEG_, OFW_, OBW_, rep ? PROBE_SCAN : 0); GRID_BAR(); }
                if (INS(9, 20)) REPS(9) { readout_phase(gw, NGW, lane, OFW_, OBW_, HG_, args.in[14], XN_); GRID_BAR(); }
            }
            if (INS(10, mb + (layer == 0 ? 4 : 6))) REPS(10) {
                pg8::Gemm g; int Kk; if (layer == 0) { g = pg8::Gemm{MIX_, (const bf16*)(ws + WS_WABOUT), 2048, 2048, 0, 0}; Kk = 2048; } else { g = pg8::Gemm{XN_, (const bf16*)(ws + WS_WHGOUT), 2048, 2048, 0, 0}; Kk = 2048; }
                pg8::ResidOrder S; S.so.init(MALL, 2048, Kk, G, bx, 1); S.nsl = layer == 0 ? 4 : 0;
                pg8::EpiResid E{rep ? XN_ : DLT_, modL + 5 * 2048, 1.f, SLAB_, rep};
                pg8::gemm_phase<pg8::EpiResid, pg8::ResidOrder, RES_ALIGN, true>(lds, g, S, E);
                GRID_BAR(); }
        }
        const int pb = f == 0 ? 1 : f == 1 ? 9 : f == 2 ? 12 : 22;
        const int jb = sub == 0 ? 0 : 6;
        if (INS(11, pb)) REPS(11) {
            const float* sg = f == 1 ? modL + 2 * 18432 + 5 * 2048 : MOD_ + 2 * 18432 + 8 * 2048;
            norm_phase(f == 0, gw, NGW, lane, H_, args.in[0], args.in[2], gainL + (sub == 0 ? 0 : 2) * 2048, modL, jb, jb + 1, XN_, SLAB_, rep ? 0 : f == 1 ? 4 : f == 2 ? 11 : 0, sg, f == 1 ? 1.f : 0.5f, false, f == 3, (f == 0 || rep) ? nullptr : DLT_); GRID_BAR(); }
        if (INS(12, pb + 1)) REPS(12) {
            pg8::Gemm g{XN_, (const bf16*)(ws + WS_WFIN) + (size_t)f * 11264 * 2048, 2048, 2048, 0, 0}; pg8::StaticOrder S; S.init(MALL, 11264, 2048, G, bx, f == 3);
            pg8::EpiSwiGLU E{HID_, FFD};
            pg8::gemm_phase<pg8::EpiSwiGLU, pg8::StaticOrder, FFN_ALIGN, FFN_SP2>(lds, g, S, E);
            GRID_BAR(); }
        if (INS(13, pb + 2)) REPS(13) {
            pg8::Gemm g{HID_, (const bf16*)(ws + WS_WFOUT) + (size_t)f * 2048 * FFD, 64, FFD, 0, 0, (size_t)256 * 64 * 2, (size_t)(FFD / 64) * 256 * 64 * 2};
#ifdef PROBE_SAMEA
            if (rep) g.tstA = 64;
#endif
            pg8::ResidOrder S; S.so.init(MALL, 2048, FFD, G, bx, 1); S.nsl = f == 3 ? 0 : 11;
            pg8::EpiResid E{rep ? XN_ : DLT_, modL + (jb + 2) * 2048, 0.5f, SLAB_, rep};
            pg8::gemm_phase<pg8::EpiResid, pg8::ResidOrder, RES_ALIGN, true>(lds, g, S, E);
            GRID_BAR(); }
        }
    {
        constexpr int f = 2;
        const int layer = f >> 1, sub = f & 1;
        const float* modL = MOD_ + (size_t)layer * 3 * 18432;
        const float* gainL = args.in[6] + (size_t)layer * 3 * 2048;
        if (sub == 1) {
            const int mb = layer == 0 ? 4 : 15;
            if (INS(1, mb)) REPS(1) { norm_phase(layer == 0 && !rep, gw, NGW, lane, H_, args.in[0], args.in[2], gainL + 2048, modL, 3, 4, XN_, SLAB_, rep ? 0 : 11, modL + 2 * 18432 + 2 * 2048, 0.5f, layer == 0, false, rep ? nullptr : DLT_); GRID_BAR(); }
            if (layer == 0) {
                if (INS(2, 5)) REPS(2) {
                    const bf16* wqkv = (const bf16*)(ws + WS_WABIN) + (size_t)1024 * 2048; const bf16* wf = (const bf16*)(ws + WS_WABIN);
                    pg8::Gemm g{XN_, wqkv, 2048, 2048, (size_t)((const char*)wf - (const char*)XN_), (size_t)((const char*)XN_ - (const char*)wqkv)};
                    pg8::ABOrder S; S.so.init(MALL, 2560, 2048, G, bx); S.G = G; S.c = bx;
                    pg8::EpiAB E{(bf16*)(ws + WS_UWL), (bf16*)(ws + WS_UWC), QB_, KB_, VB_};
                    pg8::gemm_phase<pg8::EpiAB, pg8::ABOrder, true, true>(lds, g, S, E);
                    GRID_BAR(); }
                if (INS(3, 6)) REPS(3) { qknorm_rope_phase(gw, NGW, lane, QB_, KB_, args.in[10], (const f32x2*)(ws + WS_ROPE)); fft8_prepass(lds, vcu, G, (const bf16*)(ws + WS_UWL), (bf16*)(ws + WS_DFT)); GRID_BAR(); }
                if (INS(4, 7) || (ONLY_SITE == 15 || ONLY_SITE == 16)) REPS(4) {
#ifndef PROBE_ATT
#define PROBE_ATT 3
#endif
                    if (ONLY_SITE != 15 && (!rep || (PROBE_ATT & 1))) for (int i = 0;; ++i) { const int L = i * G + vcu; if (L >= 792) break;
                        int b, hq, seq; size_t qrow; const float* ropeb;
                        if (L < 768) { b = L / 384; const int rem = L % 384; hq = rem >> 5; qrow = (size_t)b * SB + 256 + (size_t)(rem & 31) * 256; seq = SB; ropeb = (const float*)(ws + WS_ROPE) + (size_t)(rem & 31) * 256 * 128; }
                        else { const int jx = L - 768; b = jx / 12; hq = jx % 12; qrow = (size_t)b * SB; seq = 256; ropeb = nullptr; }
                        const size_t kvoff = (size_t)(b * 4 + hq / 3) * SB * 128;
                        attn::attn_dense_body<attn::bf16>((const attn::bf16*)(QB_ + qrow * 1536 + hq * 128), (const attn::bf16*)(KB_ + kvoff), (const attn::bf16*)(VB_ + kvoff), MIX_ + qrow * 2048 + 512 + hq * 128, seq, (char*)lds_raw, args.in[10], ropeb);
                        __syncthreads(); }
                    __syncthreads();
                    if (ONLY_SITE != 16 && (!rep || (PROBE_ATT & 2))) { pg8::Gemm g{(const bf16*)(ws + WS_DFTA), (const bf16*)(ws + WS_DFT), 2048, 2048, 0, 0};
                      pg8::DftOrder S{4, 32, 1, G, bx, 2048 / 64}; pg8::EpiDFT E{MIX_, 0.011048543456039806f};
                      pg8::gemm_phase<pg8::EpiDFT, pg8::DftOrder, true, true>(lds, g, S, E); }
                    if (ONLY_SITE != 16) { if (G == 256) { if (bx >= 128) ctx_dft_phase(lds, bx - 128, 128, (const bf16*)(ws + WS_UWC), MIX_); }
                                           else ctx_dft_phase(lds, vcu, G, (const bf16*)(ws + WS_UWC), MIX_); }
                    GRID_BAR(); }
            } else {
                if (INS(5, 16)) REPS(5) {
                    pg8::Gemm g{XN_, (const bf16*)(ws + WS_WHGIN), 2048, 2048, 0, 0}; pg8::StaticOrder S; S.init(MALL, 10240, 2048, G, bx);
                    pg8::EpiHG E{HG_, args.in[13]};
                    pg8::gemm_phase<pg8::EpiHG, pg8::StaticOrder, true, true>(lds, g, S, E);
                    GRID_BAR(); }
                if (INS(6, 17)) REPS(6) { hgrn_scan<false>(lds, vcu, G, HG_, USEG_, DSEG_, OFW_, OBW_, rep ? PROBE_SCAN : 0); GRID_BAR(); }
                if (INS(7, 18)) REPS(7) { hgrn_combine(vcu, G, USEG_, DSEG_); GRID_BAR(); }
                if (INS(8, 19)) REPS(8) { hgrn_scan<true>(lds, vcu, G, HG_, USEG_, DSEG_, OFW_, OBW_, rep ? PROBE_SCAN : 0); GRID_BAR(); }
                if (INS(9, 20)) REPS(9) { readout_phase(gw, NGW, lane, OFW_, OBW_, HG_, args.in[14], XN_); GRID_BAR(); }
            }
            if (INS(10, mb + (layer == 0 ? 4 : 6))) REPS(10) {
                pg8::Gemm g; int Kk; if (layer == 0) { g = pg8::Gemm{MIX_, (const bf16*)(ws + WS_WABOUT), 2048, 2048, 0, 0}; Kk = 2048; } else { g = pg8::Gemm{XN_, (const bf16*)(ws + WS_WHGOUT), 2048, 2048, 0, 0}; Kk = 2048; }
                pg8::ResidOrder S; S.so.init(MALL, 2048, Kk, G, bx, 1); S.nsl = layer == 0 ? 4 : 0;
                pg8::EpiResid E{rep ? XN_ : DLT_, modL + 5 * 2048, 1.f, SLAB_, rep};
                pg8::gemm_phase<pg8::EpiResid, pg8::ResidOrder, RES_ALIGN, true>(lds, g, S, E);
                GRID_BAR(); }
        }
        const int pb = f == 0 ? 1 : f == 1 ? 9 : f == 2 ? 12 : 22;
        const int jb = sub == 0 ? 0 : 6;
        if (INS(11, pb)) REPS(11) {
            const float* sg = f == 1 ? modL + 2 * 18432 + 5 * 2048 : MOD_ + 2 * 18432 + 8 * 2048;
            norm_phase(f == 0, gw, NGW, lane, H_, args.in[0], args.in[2], gainL + (sub == 0 ? 0 : 2) * 2048, modL, jb, jb + 1, XN_, SLAB_, rep ? 0 : f == 1 ? 4 : f == 2 ? 11 : 0, sg, f == 1 ? 1.f : 0.5f, false, f == 3, (f == 0 || rep) ? nullptr : DLT_); GRID_BAR(); }
        if (INS(12, pb + 1)) REPS(12) {
            pg8::Gemm g{XN_, (const bf16*)(ws + WS_WFIN) + (size_t)f * 11264 * 2048, 2048, 2048, 0, 0}; pg8::StaticOrder S; S.init(MALL, 11264, 2048, G, bx, f == 3);
            pg8::EpiSwiGLU E{HID_, FFD};
            pg8::gemm_phase<pg8::EpiSwiGLU, pg8::StaticOrder, FFN_ALIGN, FFN_SP2>(lds, g, S, E);
            GRID_BAR(); }
        if (INS(13, pb + 2)) REPS(13) {
            pg8::Gemm g{HID_, (const bf16*)(ws + WS_WFOUT) + (size_t)f * 2048 * FFD, 64, FFD, 0, 0, (size_t)256 * 64 * 2, (size_t)(FFD / 64) * 256 * 64 * 2};
#ifdef PROBE_SAMEA
            if (rep) g.tstA = 64;
#endif
            pg8::ResidOrder S; S.so.init(MALL, 2048, FFD, G, bx, 1); S.nsl = f == 3 ? 0 : 11;
            pg8::EpiResid E{rep ? XN_ : DLT_, modL + (jb + 2) * 2048, 0.5f, SLAB_, rep};
            pg8::gemm_phase<pg8::EpiResid, pg8::ResidOrder, RES_ALIGN, true>(lds, g, S, E);
            GRID_BAR(); }
        }
    {
        constexpr int f = 3;
        const int layer = f >> 1, sub = f & 1;
        const float* modL = MOD_ + (size_t)layer * 3 * 18432;
        const float* gainL = args.in[6] + (size_t)layer * 3 * 2048;
        if (sub == 1) {
            const int mb = layer == 0 ? 4 : 15;
            if (INS(1, mb)) REPS(1) { norm_phase(layer == 0 && !rep, gw, NGW, lane, H_, args.in[0], args.in[2], gainL + 2048, modL, 3, 4, XN_, SLAB_, rep ? 0 : 11, modL + 2 * 18432 + 2 * 2048, 0.5f, layer == 0, false, rep ? nullptr : DLT_); GRID_BAR(); }
            if (layer == 0) {
                if (INS(2, 5)) REPS(2) {
                    const bf16* wqkv = (const bf16*)(ws + WS_WABIN) + (size_t)1024 * 2048; const bf16* wf = (const bf16*)(ws + WS_WABIN);
                    pg8::Gemm g{XN_, wqkv, 2048, 2048, (size_t)((const char*)wf - (const char*)XN_), (size_t)((const char*)XN_ - (const char*)wqkv)};
                    pg8::ABOrder S; S.so.init(MALL, 2560, 2048, G, bx); S.G = G; S.c = bx;
                    pg8::EpiAB E{(bf16*)(ws + WS_UWL), (bf16*)(ws + WS_UWC), QB_, KB_, VB_};
                    pg8::gemm_phase<pg8::EpiAB, pg8::ABOrder, true, true>(lds, g, S, E);
                    GRID_BAR(); }
                if (INS(3, 6)) REPS(3) { qknorm_rope_phase(gw, NGW, lane, QB_, KB_, args.in[10], (const f32x2*)(ws + WS_ROPE)); fft8_prepass(lds, vcu, G, (const bf16*)(ws + WS_UWL), (bf16*)(ws + WS_DFT)); GRID_BAR(); }
                if (INS(4, 7) || (ONLY_SITE == 15 || ONLY_SITE == 16)) REPS(4) {
#ifndef PROBE_ATT
#define PROBE_ATT 3
#endif
                    if (ONLY_SITE != 15 && (!rep || (PROBE_ATT & 1))) for (int i = 0;; ++i) { const int L = i * G + vcu; if (L >= 792) break;
                        int b, hq, seq; size_t qrow; const float* ropeb;
                        if (L < 768) { b = L / 384; const int rem = L % 384; hq = rem >> 5; qrow = (size_t)b * SB + 256 + (size_t)(rem & 31) * 256; seq = SB; ropeb = (const float*)(ws + WS_ROPE) + (size_t)(rem & 31) * 256 * 128; }
                        else { const int jx = L - 768; b = jx / 12; hq = jx % 12; qrow = (size_t)b * SB; seq = 256; ropeb = nullptr; }
                        const size_t kvoff = (size_t)(b * 4 + hq / 3) * SB * 128;
                        attn::attn_dense_body<attn::bf16>((const attn::bf16*)(QB_ + qrow * 1536 + hq * 128), (const attn::bf16*)(KB_ + kvoff), (const attn::bf16*)(VB_ + kvoff), MIX_ + qrow * 2048 + 512 + hq * 128, seq, (char*)lds_raw, args.in[10], ropeb);
                        __syncthreads(); }
                    __syncthreads();
                    if (ONLY_SITE != 16 && (!rep || (PROBE_ATT & 2))) { pg8::Gemm g{(const bf16*)(ws + WS_DFTA), (const bf16*)(ws + WS_DFT), 2048, 2048, 0, 0};
                      pg8::DftOrder S{4, 32, 1, G, bx, 2048 / 64}; pg8::EpiDFT E{MIX_, 0.011048543456039806f};
                      pg8::gemm_phase<pg8::EpiDFT, pg8::DftOrder, true, true>(lds, g, S, E); }
                    if (ONLY_SITE != 16) { if (G == 256) { if (bx >= 128) ctx_dft_phase(lds, bx - 128, 128, (const bf16*)(ws + WS_UWC), MIX_); }
                                           else ctx_dft_phase(lds, vcu, G, (const bf16*)(ws + WS_UWC), MIX_); }
                    GRID_BAR(); }
            } else {
                if (INS(5, 16)) REPS(5) {
                    pg8::Gemm g{XN_, (const bf16*)(ws + WS_WHGIN), 2048, 2048, 0, 0}; pg8::StaticOrder S; S.init(MALL, 10240, 2048, G, bx);
                    pg8::EpiHG E{HG_, args.in[13]};
                    pg8::gemm_phase<pg8::EpiHG, pg8::StaticOrder, true, true>(lds, g, S, E);
                    GRID_BAR(); }
                if (INS(6, 17)) REPS(6) { hgrn_scan<false>(lds, vcu, G, HG_, USEG_, DSEG_, OFW_, OBW_, rep ? PROBE_SCAN : 0); GRID_BAR(); }
                if (INS(7, 18)) REPS(7) { hgrn_combine(vcu, G, USEG_, DSEG_); GRID_BAR(); }
                if (INS(8, 19)) REPS(8) { hgrn_scan<true>(lds, vcu, G, HG_, USEG_, DSEG_, OFW_, OBW_, rep ? PROBE_SCAN : 0); GRID_BAR(); }
                if (INS(9, 20)) REPS(9) { readout_phase(gw, NGW, lane, OFW_, OBW_, HG_, args.in[14], XN_); GRID_BAR(); }
            }
            if (INS(10, mb + (layer == 0 ? 4 : 6))) REPS(10) {
                pg8::Gemm g; int Kk; if (layer == 0) { g = pg8::Gemm{MIX_, (const bf16*)(ws + WS_WABOUT), 2048, 2048, 0, 0}; Kk = 2048; } else { g = pg8::Gemm{XN_, (const bf16*)(ws + WS_WHGOUT), 2048, 2048, 0, 0}; Kk = 2048; }
                pg8::ResidOrder S; S.so.init(MALL, 2048, Kk, G, bx, 1); S.nsl = layer == 0 ? 4 : 0;
                pg8::EpiResid E{rep ? XN_ : DLT_, modL + 5 * 2048, 1.f, SLAB_, rep};
                pg8::gemm_phase<pg8::EpiResid, pg8::ResidOrder, RES_ALIGN, true>(lds, g, S, E);
                GRID_BAR(); }
        }
        const int pb = f == 0 ? 1 : f == 1 ? 9 : f == 2 ? 12 : 22;
        const int jb = sub == 0 ? 0 : 6;
        if (INS(11, pb)) REPS(11) {
            const float* sg = f == 1 ? modL + 2 * 18432 + 5 * 2048 : MOD_ + 2 * 18432 + 8 * 2048;
            norm_phase(f == 0, gw, NGW, lane, H_, args.in[0], args.in[2], gainL + (sub == 0 ? 0 : 2) * 2048, modL, jb, jb + 1, XN_, SLAB_, rep ? 0 : f == 1 ? 4 : f == 2 ? 11 : 0, sg, f == 1 ? 1.f : 0.5f, false, f == 3, (f == 0 || rep) ? nullptr : DLT_); GRID_BAR(); }
        if (INS(12, pb + 1)) REPS(12) {
            pg8::Gemm g{XN_, (const bf16*)(ws + WS_WFIN) + (size_t)f * 11264 * 2048, 2048, 2048, 0, 0}; pg8::StaticOrder S; S.init(MALL, 11264, 2048, G, bx, f == 3);
            pg8::EpiSwiGLU E{HID_, FFD};
            pg8::gemm_phase<pg8::EpiSwiGLU, pg8::StaticOrder, FFN_ALIGN, FFN_SP2>(lds, g, S, E);
            GRID_BAR(); }
        if (INS(13, pb + 2)) REPS(13) {
            pg8::Gemm g{HID_, (const bf16*)(ws + WS_WFOUT) + (size_t)f * 2048 * FFD, 64, FFD, 0, 0, (size_t)256 * 64 * 2, (size_t)(FFD / 64) * 256 * 64 * 2};
#ifdef PROBE_SAMEA
            if (rep) g.tstA = 64;
#endif
            pg8::ResidOrder S; S.so.init(MALL, 2048, FFD, G, bx, 1); S.nsl = f == 3 ? 0 : 11;
            pg8::EpiResid E{rep ? XN_ : DLT_, modL + (jb + 2) * 2048, 0.5f, SLAB_, rep};
            pg8::gemm_phase<pg8::EpiResid, pg8::ResidOrder, RES_ALIGN, true>(lds, g, S, E);
            GRID_BAR(); }
        }
#ifdef PROBE_BARS
    for (int q = 0; q < PROBE_BARS; ++q) GRID_BAR();
#endif
    if (INS(14, 25)) REPS(14) final_phase(gw, NGW, lane, H_, args.in[16], args.out, DLT_);
#undef INS
#undef GRID_BAR
}

extern "C" void kernel_launch(void* const* d_in, const int* in_sizes, int n_in, void* d_out, int out_size, void* d_ws, size_t ws_size, hipStream_t stream) {
    static int grid = 0;
    if (grid == 0) {
        if (n_in != 17 || in_sizes[0] != NBATCH * SEQ * DM || out_size != NBATCH * SEQ * DM || ws_size < WS_END) {
            fprintf(stderr, "kernel_launch: shape mismatch: n_in %d in0 %d out %d ws %zu (need %zu); nothing launched\n", n_in, n_in > 0 ? in_sizes[0] : -1, out_size, ws_size, (size_t)WS_END); grid = -1; return; }
        int dev = 0, cus = 0, per_cu = 0;
        if (hipGetDevice(&dev) != hipSuccess || hipDeviceGetAttribute(&cus, hipDeviceAttributeMultiprocessorCount, dev) != hipSuccess) { grid = -1; return; }
        if (hipFuncSetAttribute((const void*)mk_fwd, hipFuncAttributeMaxDynamicSharedMemorySize, LDS_BYTES) != hipSuccess) { fprintf(stderr, "kernel_launch: hipFuncSetAttribute(%d) failed\n", LDS_BYTES); grid = -1; return; }
        if (hipOccupancyMaxActiveBlocksPerMultiprocessor(&per_cu, (const void*)mk_fwd, NWAVES * 64, LDS_BYTES) != hipSuccess || per_cu < 1)
            fprintf(stderr, "kernel_launch: note: occupancy query reports %d workgroups per CU\n", per_cu);
        (void)hipGetLastError();
        grid = cus;
    }
    if (grid < 0) return;
    if (hipMemsetAsync((char*)d_ws + WS_CTL, 0, CTL_ZERO_BYTES, stream) != hipSuccess) { fprintf(stderr, "kernel_launch: memset failed\n"); return; }
    Args a{};
    for (int i = 0; i < 17; ++i) a.in[i] = (const float*)d_in[i];
    a.out = (float*)d_out; a.ws = (unsigned char*)d_ws;
#if MK_SPLIT
    for (int ph = 0; ph < NPH; ++ph) { a.ph_lo = ph; a.ph_hi = ph + 1; hipLaunchKernelGGL(mk_fwd, dim3(grid), dim3(NWAVES * 64), LDS_BYTES, stream, a); }
#else
    a.ph_lo = 0; a.ph_hi = NPH; hipLaunchKernelGGL(mk_fwd, dim3(grid), dim3(NWAVES * 64), LDS_BYTES, stream, a);
#endif
    const hipError_t le = hipPeekAtLastError();
    if (le != hipSuccess) fprintf(stderr, "kernel_launch: launch failed: %s\n", hipGetErrorName(le));
}
```
